# Optimizing an MI355X kernel written in HIP

```python
import math
import jax, jax.numpy as jnp
from jax import lax
import numpy as np

D_MODEL = 4096
BATCH = 2
SEQ = 8192
DEPTH = 1

N_HEADS = 16
HEAD_DIM = 64
ATTN_WIDTH = N_HEADS * 2 * HEAD_DIM
SSM_WIDTH = D_MODEL // 2
SSM_GROUP = 16
N_GROUPS = SSM_WIDTH // SSM_GROUP
STATE = 64
D_FF = 11008
CONV_W = 3
Q_BLOCK = 128
SCAN_CHUNK = 128
EPS = 1e-6
IN_SPLITS = [ATTN_WIDTH, 2 * ATTN_WIDTH, 3 * ATTN_WIDTH, 3 * ATTN_WIDTH + SSM_WIDTH,
             3 * ATTN_WIDTH + SSM_WIDTH + D_MODEL]
IN_WIDTH = 3 * ATTN_WIDTH + SSM_WIDTH + 2 * D_MODEL

kernel_name = "hybrid_diffattn_s5_convffn_adaln"


def rmsnorm(x, g):
    xf = x.astype(jnp.float32)
    y = xf * lax.rsqrt(jnp.mean(xf * xf, axis=-1, keepdims=True) + EPS)
    return (y * g.astype(jnp.float32)).astype(x.dtype)


def diff_attention(q, k, v, lq1, lk1, lq2, lk2, subln_g, lam_init):
    B, L = q.shape[0], q.shape[1]
    nb = L // Q_BLOCK
    f32 = jnp.float32
    scale = HEAD_DIM ** -0.5
    lam = (jnp.exp(jnp.sum(lq1.astype(f32) * lk1.astype(f32)))
           - jnp.exp(jnp.sum(lq2.astype(f32) * lk2.astype(f32))) + lam_init)
    slopes = jnp.exp2(-8.0 * jnp.arange(1, N_HEADS + 1, dtype=f32) / N_HEADS)
    qb = q.astype(f32).reshape(B, nb, Q_BLOCK, N_HEADS, 2, HEAD_DIM).transpose(1, 0, 3, 4, 2, 5)
    kf = k.astype(f32).transpose(0, 2, 3, 1, 4)
    vf = v.astype(f32).transpose(0, 2, 1, 3)
    kpos = jnp.arange(L)

    def block(args):
        qblk, start = args
        s = jnp.einsum('bhjqd,bhjkd->bhjqk', qblk, kf) * scale
        qpos = start + jnp.arange(Q_BLOCK)
        dist = (qpos[:, None] - kpos[None, :]).astype(f32)
        bias = -slopes[:, None, None, None] * dist
        s = jnp.where(dist >= 0, s + bias, -jnp.inf)
        p = jax.nn.softmax(s, axis=-1)
        w = p[:, :, 0] - lam * p[:, :, 1]
        return jnp.einsum('bhqk,bhke->bhqe', w, vf)

    o = lax.map(block, (qb, jnp.arange(nb) * Q_BLOCK))
    o = rmsnorm(o, subln_g) * (1.0 - lam_init)
    return o.transpose(1, 0, 3, 2, 4).reshape(B, L, ATTN_WIDTH).astype(q.dtype)


def _ssm_combine(e1, e2):
    a1, b1 = e1
    a2, b2 = e2
    return a1 * a2, a2 * b1 + b2


def s5_branch(u, a_re, a_im, b_re, b_im, c_re, c_im, d_skip, log_dt, w_glu):
    B, L = u.shape[0], u.shape[1]
    f32 = jnp.float32
    nc = L // SCAN_CHUNK
    uf = u.astype(f32)
    u_chunks = uf.reshape(B, nc, SCAN_CHUNK, N_GROUPS, SSM_GROUP).transpose(1, 0, 2, 3, 4)
    lam = lax.complex(a_re.astype(f32), a_im.astype(f32))
    dt = jnp.exp(log_dt.astype(f32))[:, None]
    lam_dt = lam * dt
    a_bar = jnp.exp(lam_dt)
    b_mat = lax.complex(b_re.astype(f32), b_im.astype(f32))
    b_bar = ((a_bar - 1.0) / lam)[..., None] * b_mat
    c_mat = lax.complex(c_re.astype(f32), c_im.astype(f32))
    a_pow = jnp.exp(lam_dt[None] * jnp.arange(1, SCAN_CHUNK + 1, dtype=f32)[:, None, None])

    def chunk(carry, u_c):
        bu = jnp.einsum('gpc,btgc->btgp', b_bar, u_c.astype(jnp.complex64))
        a = jnp.broadcast_to(a_bar, bu.shape)
        _, xs = lax.associative_scan(_ssm_combine, (a, bu), axis=1)
        xs = xs + a_pow[None] * carry[:, None]
        y = jnp.einsum('gcp,btgp->btgc', c_mat, xs).real
        return xs[:, -1], y

    carry0 = jnp.zeros((B, N_GROUPS, STATE), jnp.complex64)
    _, y = lax.scan(chunk, carry0, u_chunks)
    y = y.transpose(1, 0, 2, 3, 4).reshape(B, L, SSM_WIDTH) + d_skip.astype(f32) * uf
    z = jax.nn.gelu(y)
    out = z * jax.nn.sigmoid(z @ w_glu.astype(f32))
    return out.astype(u.dtype)


def conv_ffn(h, w_up, conv_w, conv_b, w_down):
    L = h.shape[1]
    up = h @ w_up
    pad = jnp.pad(up, ((0, 0), (CONV_W - 1, 0), (0, 0)))
    conv = conv_b
    for j in range(CONV_W):
        conv = conv + conv_w[j] * pad[:, j:j + L]
    a, g = jnp.split(conv, 2, axis=-1)
    return (jax.nn.silu(g) * a) @ w_down


def setup_inputs(seed: int = 0) -> dict:
    key = jax.random.key(seed)
    ks = jax.random.split(key, 32)
    f32 = jnp.float32

    def nrm(k, shape, s):
        return jax.random.normal(k, shape, f32) * s

    P, G, c = STATE, N_GROUPS, SSM_GROUP
    return {
        "x": nrm(ks[0], (BATCH, SEQ, D_MODEL), 1.0),
        "c": nrm(ks[1], (BATCH, D_MODEL), 1.0),
        "ada_w": nrm(ks[2], (DEPTH, D_MODEL, 6 * D_MODEL), 0.5 * D_MODEL ** -0.5),
        "ada_b": nrm(ks[3], (DEPTH, 6 * D_MODEL), 0.01),
        "norm1_g": 1.0 + nrm(ks[4], (DEPTH, D_MODEL), 0.02),
        "w_in": nrm(ks[5], (DEPTH, D_MODEL, IN_WIDTH), D_MODEL ** -0.5),
        "lq1": nrm(ks[6], (DEPTH, HEAD_DIM), 0.1),
        "lk1": nrm(ks[7], (DEPTH, HEAD_DIM), 0.1),
        "lq2": nrm(ks[8], (DEPTH, HEAD_DIM), 0.1),
        "lk2": nrm(ks[9], (DEPTH, HEAD_DIM), 0.1),
        "subln_g": 1.0 + nrm(ks[10], (DEPTH, 2 * HEAD_DIM), 0.02),
        "a_re": -0.5 + nrm(ks[11], (DEPTH, G, P), 0.01),
        "a_im": math.pi * jnp.arange(P, dtype=f32) + nrm(ks[12], (DEPTH, G, P), 0.01),
        "b_re": nrm(ks[13], (DEPTH, G, P, c), (2 * c) ** -0.5),
        "b_im": nrm(ks[14], (DEPTH, G, P, c), (2 * c) ** -0.5),
        "c_re": nrm(ks[15], (DEPTH, G, c, P), (2 * P) ** -0.5 * 4.0),
        "c_im": nrm(ks[16], (DEPTH, G, c, P), (2 * P) ** -0.5 * 4.0),
        "d_skip": nrm(ks[17], (DEPTH, SSM_WIDTH), 1.0),
        "log_dt": jax.random.uniform(ks[18], (DEPTH, G), f32, math.log(0.001), math.log(0.1)),
        "w_glu": nrm(ks[19], (DEPTH, SSM_WIDTH, SSM_WIDTH), SSM_WIDTH ** -0.5),
        "w_attn_br": nrm(ks[20], (DEPTH, ATTN_WIDTH, D_MODEL), ATTN_WIDTH ** -0.5),
        "w_ssm_br": nrm(ks[21], (DEPTH, SSM_WIDTH, D_MODEL), SSM_WIDTH ** -0.5),
        "w_out": nrm(ks[22], (DEPTH, D_MODEL, D_MODEL), D_MODEL ** -0.5),
        "norm2_g": 1.0 + nrm(ks[23], (DEPTH, D_MODEL), 0.02),
        "w_up": nrm(ks[24], (DEPTH, D_MODEL, 2 * D_FF), D_MODEL ** -0.5),
        "conv_w": nrm(ks[25], (DEPTH, CONV_W, 2 * D_FF), CONV_W ** -0.5),
        "conv_b": nrm(ks[26], (DEPTH, 2 * D_FF), 0.01),
        "w_down": nrm(ks[27], (DEPTH, D_FF, D_MODEL), D_FF ** -0.5),
        "final_g": 1.0 + nrm(ks[28], (D_MODEL,), 0.02),
    }


def reference(x, c, ada_w, ada_b, norm1_g, w_in, lq1, lk1, lq2, lk2, subln_g,
              a_re, a_im, b_re, b_im, c_re, c_im, d_skip, log_dt, w_glu,
              w_attn_br, w_ssm_br, w_out, norm2_g, w_up, conv_w, conv_b, w_down,
              final_g):
    B, L = x.shape[0], x.shape[1]
    for l in range(DEPTH):
        lam_init = 0.8 - 0.6 * math.exp(-0.3 * l)
        mod = (c @ ada_w[l] + ada_b[l])[:, None, :]
        sh1, sc1, g1, sh2, sc2, g2 = jnp.split(mod, 6, axis=-1)

        h = rmsnorm(x, norm1_g[l]) * (1.0 + sc1) + sh1
        proj = h @ w_in[l]
        q, k, v, u, ga, gs = jnp.split(proj, IN_SPLITS, axis=-1)
        q = q.reshape(B, L, N_HEADS, 2, HEAD_DIM)
        k = k.reshape(B, L, N_HEADS, 2, HEAD_DIM)
        v = v.reshape(B, L, N_HEADS, 2 * HEAD_DIM)
        attn = diff_attention(q, k, v, lq1[l], lk1[l], lq2[l], lk2[l], subln_g[l], lam_init)
        ssm = s5_branch(u, a_re[l], a_im[l], b_re[l], b_im[l], c_re[l], c_im[l],
                        d_skip[l], log_dt[l], w_glu[l])
        merged = (jax.nn.sigmoid(ga) * (attn @ w_attn_br[l])
                  + jax.nn.sigmoid(gs) * (ssm @ w_ssm_br[l]))
        x = x + g1 * (merged @ w_out[l])

        h2 = rmsnorm(x, norm2_g[l]) * (1.0 + sc2) + sh2
        x = x + g2 * conv_ffn(h2, w_up[l], conv_w[l], conv_b[l], w_down[l])
    return rmsnorm(x, final_g)
```

```cpp
#include <hip/hip_runtime.h>
#include <cstdio>
#include <cstdint>

#ifndef MK_PER_PHASE
#define MK_PER_PHASE 0
#endif

#define GAS __attribute__((address_space(1)))
#define LAS __attribute__((address_space(3)))
typedef unsigned short bf16;
typedef unsigned v4u __attribute__((ext_vector_type(4)));
typedef unsigned v2u __attribute__((ext_vector_type(2)));
typedef float f32x2 __attribute__((ext_vector_type(2)));
typedef float f32x4 __attribute__((ext_vector_type(4)));
typedef float f32x16 __attribute__((ext_vector_type(16)));
typedef short bf16x8 __attribute__((ext_vector_type(8)));
typedef short s16x4 __attribute__((ext_vector_type(4)));
typedef GAS unsigned gu32;

constexpr int BATCH = 2, SEQ = 8192, M = BATCH * SEQ, D = 4096;
constexpr int NHEAD = 16, AW = 2048, SW = 2048, NIN = 16384, FF = 11008, NUP = 2 * FF;
constexpr int NGRP = 128, SGC = 16, NSTATE = 64, TCH = 64, NCH = SEQ / TCH;
constexpr float EPS = 1e-6f, LAM_INIT = 0.2f;
constexpr float LOG2E = 1.4426950408889634f;
constexpr int QK_PITCH = 8192;

constexpr size_t MiB = 1u << 20;
constexpr size_t WS_CTL = 0, CTL_ZERO_BYTES = 64 * 1024;
constexpr size_t WS_WIN = 1 * MiB;
constexpr size_t WS_Z = 1 * MiB, WS_SSM = 65 * MiB;
constexpr size_t WS_WGLU = 129 * MiB, WS_WA = 137 * MiB, WS_WS = 153 * MiB, WS_WOUT = 169 * MiB, WS_WUP = 201 * MiB, WS_WDN = 373 * MiB;
constexpr size_t WS_H = 459 * MiB;
constexpr size_t WS_QKVU = 587 * MiB, WS_GATES = 843 * MiB;
constexpr size_t WS_ACT = 587 * MiB;
constexpr size_t WS_ATT = 1099 * MiB;
constexpr size_t WS_RAW = 1163 * MiB;
constexpr size_t WS_M2 = 1206 * MiB, WS_M3 = 1238 * MiB;
constexpr size_t WS_KTAB = 1270 * MiB;
constexpr size_t WS_MOD = 1275 * MiB;
constexpr size_t WS_A64 = WS_MOD + 256 * 1024;
constexpr size_t WS_END = 1276 * MiB;
constexpr int CW_TMO = 0, CW_BAR = 4096, CW_QATT = 8192, CW_QT0 = 8256, CW_KMAX = 12288;

constexpr int RING_BYTES = 147456, LDS_BYTES = RING_BYTES + 1024, LDSCTL_OFF = RING_BYTES, MISC_OFF = LDSCTL_OFF + 320;
constexpr int NWAVES = 8;

__device__ __forceinline__ unsigned f2bf(float f) { unsigned u = __builtin_bit_cast(unsigned, f); return (u + 0x7fffu + ((u >> 16) & 1u)) >> 16; }
__device__ __forceinline__ unsigned pk2(float lo, float hi) { unsigned r; asm("v_cvt_pk_bf16_f32 %0, %1, %2" : "=v"(r) : "v"(lo), "v"(hi)); return r; }
__device__ __forceinline__ float bflo(unsigned w) { return __builtin_bit_cast(float, w << 16); }
__device__ __forceinline__ float bfhi(unsigned w) { return __builtin_bit_cast(float, w & 0xffff0000u); }
__device__ __forceinline__ float sigmoidf_(float x) { return __builtin_amdgcn_rcpf(1.0f + __builtin_amdgcn_exp2f(-x * LOG2E)); }
__device__ __forceinline__ float wave_sum(float v) {
#pragma unroll
    for (int o = 1; o < 64; o <<= 1) v += __shfl_xor(v, o);
    return v;
}
#define LDS_WAIT() asm volatile("s_waitcnt lgkmcnt(0)" ::: "memory")
#ifndef WBITS
#define WBITS 5
#endif
#ifndef ABITS
#define ABITS 6
#endif
__device__ __forceinline__ unsigned pk2a(float lo, float hi) {
    constexpr unsigned SH = 16 + (7 - ABITS);
    if (ABITS >= 7) return pk2(lo, hi);
    const unsigned a = (__builtin_bit_cast(unsigned, lo) + (1u << (SH - 1))) & ~((1u << SH) - 1u), b = (__builtin_bit_cast(unsigned, hi) + (1u << (SH - 1))) & ~((1u << SH) - 1u);
    return (a >> 16) | (b & 0xffff0000u);
}
__device__ __forceinline__ unsigned pk2w(float lo, float hi) {
    constexpr unsigned SH = 16 + (7 - WBITS), HALF_ = (1u << (SH - 1)) - 1u;
    unsigned a = __builtin_bit_cast(unsigned, lo), b = __builtin_bit_cast(unsigned, hi);
    a = ((a + HALF_ + ((a >> SH) & 1u)) >> SH) << (SH - 16); b = ((b + HALF_ + ((b >> SH) & 1u)) >> SH) << (SH - 16);
    return (a & 0xffffu) | (b << 16);
}

namespace pg8 {
constexpr int BM = 256, BK = 64, HALF = 128, HTB = HALF * BK * 2, STAGE_BYTES = 8 * HTB, NXCD = 8, WGM = 8;
__host__ __device__ __forceinline__ int lds_byte(int r, int c) { const int st = (r >> 4) * 2 + (c >> 5), rr = r & 15, cc = c & 31, ob = rr * 64 + cc * 2; return st * 1024 + (ob ^ (((ob >> 9) & 1) << 5)); }
__host__ __device__ __forceinline__ void stage_rc(int b, int& R, int& C) { const int st = b / 1024, sb = b % 1024, swz = sb ^ (((sb >> 9) & 1) << 5); R = (st >> 1) * 16 + swz / 64; C = (st & 1) * 32 + (swz % 64) / 2; }
__host__ __device__ __forceinline__ int perm32(int rho) { const int n = rho >> 4, i = rho & 15; return 8 * (i >> 2) + 4 * n + (i & 3); }

struct Unit { int pm, pn, z; };
struct Gemm { const bf16* A0; const bf16* B0; const bf16* A1; const bf16* B1; int M, N, K; };

struct StaticOrder {
    int nM, nN, nwg, G, c, dsh;
    __device__ void init(int M_, int N_, int G_, int c_, int dsh_) { nM = M_ / BM; nN = N_ / BM; nwg = nM * nN; G = G_; c = c_; dsh = dsh_; }
    __device__ bool next(int i, Unit& u) const {
        const int ii = i >> dsh; u.z = i & ((1 << dsh) - 1);
        const long L = (long)ii * G + c; if (L >= nwg) return false;
        int wgid = (int)L; { const int q = nwg / NXCD, r = nwg % NXCD, xcd = wgid % NXCD, off = wgid / NXCD; wgid = (xcd < r ? xcd * (q + 1) : r * (q + 1) + (xcd - r) * q) + off; }
        const int nig = WGM * nN, gid = wgid / nig, fm = gid * WGM, gsz = (nM - fm) < WGM ? (nM - fm) : WGM;
        u.pm = fm + ((wgid % nig) % gsz); u.pn = (wgid % nig) / gsz; return true;
    }
};

typedef f32x4 Acc[2][2][4][2];

struct EpiInProj {
    static constexpr bool PERM = true;
    bf16* QKVU; bf16* GATES; float qscale;
    __device__ __forceinline__ void operator()(const Acc& acc, const Unit& u, int wr, int wc, int fr, int fq) const {
        const int row0 = u.pm * BM + wr * 64 + fr; const bool gate = u.pn >= 32;
        bf16* base = gate ? GATES : QKVU; const int col0 = (gate ? u.pn - 32 : u.pn) * BM + wc * 32 + 8 * fq;
        const float sc = (u.pn < 8) ? qscale : 1.f;
#pragma unroll
        for (int ai = 0; ai < 2; ++ai)
#pragma unroll
            for (int m = 0; m < 4; ++m) { bf16* rowp = base + (size_t)(row0 + ai * HALF + m * 16) * QK_PITCH + col0;
#pragma unroll
                for (int bj = 0; bj < 2; ++bj) { f32x4 v0 = acc[ai][bj][m][0], v1 = acc[ai][bj][m][1];
                    if (gate) { v0 = (f32x4){sigmoidf_(v0[0]), sigmoidf_(v0[1]), sigmoidf_(v0[2]), sigmoidf_(v0[3])}; v1 = (f32x4){sigmoidf_(v1[0]), sigmoidf_(v1[1]), sigmoidf_(v1[2]), sigmoidf_(v1[3])}; }
                    else { v0 = v0 * sc; v1 = v1 * sc; }
                    v4u w; w.x = pk2(v0[0], v0[1]); w.y = pk2(v0[2], v0[3]); w.z = pk2(v1[0], v1[1]); w.w = pk2(v1[2], v1[3]);
                    *(v4u*)(rowp + bj * HALF) = w; } }
    }
};
struct EpiGlu {
    static constexpr bool PERM = true;
    const bf16* Z; bf16* O;
    __device__ __forceinline__ void operator()(const Acc& acc, const Unit& u, int wr, int wc, int fr, int fq) const {
        const int row0 = u.pm * BM + wr * 64 + fr, col0 = u.pn * BM + wc * 32 + 8 * fq;
        v4u zz[2][4][2];
#pragma unroll
        for (int ai = 0; ai < 2; ++ai)
#pragma unroll
            for (int m = 0; m < 4; ++m)
#pragma unroll
                for (int bj = 0; bj < 2; ++bj) zz[ai][m][bj] = *(const v4u*)(Z + (size_t)(row0 + ai * HALF + m * 16) * SW + col0 + bj * HALF);
#pragma unroll
        for (int ai = 0; ai < 2; ++ai)
#pragma unroll
            for (int m = 0; m < 4; ++m)
#pragma unroll
                for (int bj = 0; bj < 2; ++bj) { const f32x4 v0 = acc[ai][bj][m][0], v1 = acc[ai][bj][m][1]; const v4u z4 = zz[ai][m][bj];
                    v4u w; w.x = pk2a(bflo(z4.x) * sigmoidf_(v0[0]), bfhi(z4.x) * sigmoidf_(v0[1])); w.y = pk2a(bflo(z4.y) * sigmoidf_(v0[2]), bfhi(z4.y) * sigmoidf_(v0[3]));
                    w.z = pk2a(bflo(z4.z) * sigmoidf_(v1[0]), bfhi(z4.z) * sigmoidf_(v1[1])); w.w = pk2a(bflo(z4.w) * sigmoidf_(v1[2]), bfhi(z4.w) * sigmoidf_(v1[3]));
                    *(v4u*)(O + (size_t)(row0 + ai * HALF + m * 16) * SW + col0 + bj * HALF) = w; }
    }
};
struct EpiMerge {
    static constexpr bool PERM = true;
    const bf16* GATES; bf16* MG;
    __device__ __forceinline__ bool keep(const Unit& u) const { return u.z == 0; }
    __device__ __forceinline__ void operator()(Acc& acc, const Unit& u, int wr, int wc, int fr, int fq) const {
        const int row0 = u.pm * BM + wr * 64 + fr, col0 = u.pn * BM + wc * 32 + 8 * fq;
        if (u.z == 0) {
#pragma unroll
            for (int ai = 0; ai < 2; ++ai) {
                v4u ga[4][2], gs[4][2];
#pragma unroll
                for (int m = 0; m < 4; ++m)
#pragma unroll
                    for (int bj = 0; bj < 2; ++bj) { const size_t r = (size_t)(row0 + ai * HALF + m * 16);
                        ga[m][bj] = *(const v4u*)(GATES + r * QK_PITCH + col0 + bj * HALF);
                        gs[m][bj] = *(const v4u*)(GATES + r * QK_PITCH + D + col0 + bj * HALF); }
#pragma unroll
                for (int m = 0; m < 4; ++m)
#pragma unroll
                    for (int bj = 0; bj < 2; ++bj) { const v4u a4 = ga[m][bj], s4 = gs[m][bj];
                        const unsigned aw[4] = {a4.x, a4.y, a4.z, a4.w}, sw[4] = {s4.x, s4.y, s4.z, s4.w};
#pragma unroll
                        for (int q = 0; q < 4; ++q) { const float rl = bflo(aw[q]) * __builtin_amdgcn_rcpf(fmaxf(bflo(sw[q]), 1e-30f)), rh = bfhi(aw[q]) * __builtin_amdgcn_rcpf(fmaxf(bfhi(sw[q]), 1e-30f));
                            acc[ai][bj][m][q >> 1][(q & 1) * 2] *= rl; acc[ai][bj][m][q >> 1][(q & 1) * 2 + 1] *= rh; } }
            }
        } else {
            v4u gg[2][4][2];
#pragma unroll
            for (int ai = 0; ai < 2; ++ai)
#pragma unroll
                for (int m = 0; m < 4; ++m)
#pragma unroll
                    for (int bj = 0; bj < 2; ++bj) gg[ai][m][bj] = *(const v4u*)(GATES + (size_t)(row0 + ai * HALF + m * 16) * QK_PITCH + D + col0 + bj * HALF);
#pragma unroll
            for (int ai = 0; ai < 2; ++ai)
#pragma unroll
                for (int m = 0; m < 4; ++m)
#pragma unroll
                    for (int bj = 0; bj < 2; ++bj) { const f32x4 v0 = acc[ai][bj][m][0], v1 = acc[ai][bj][m][1]; const v4u g4 = gg[ai][m][bj];
                        v4u w; w.x = pk2a(bflo(g4.x) * v0[0], bfhi(g4.x) * v0[1]); w.y = pk2a(bflo(g4.y) * v0[2], bfhi(g4.y) * v0[3]); w.z = pk2a(bflo(g4.z) * v1[0], bfhi(g4.z) * v1[1]); w.w = pk2a(bflo(g4.w) * v1[2], bfhi(g4.w) * v1[3]);
                        *(v4u*)(MG + (size_t)(row0 + ai * HALF + m * 16) * D + col0 + bj * HALF) = w; }
        }
    }
};
template <bool IN_BF16, bool OUT_BF16>
struct EpiResid {
    static constexpr bool PERM = true;
    const void* base; void* out; const float* gate;
    __device__ __forceinline__ void operator()(const Acc& acc, const Unit& u, int wr, int wc, int fr, int fq) const {
        const int row0 = u.pm * BM + wr * 64 + fr, col0 = u.pn * BM + wc * 32 + 8 * fq; const float* gp = gate + (u.pm >= (SEQ / BM) ? 6 * D : 0) + col0;
        f32x4 gv[2][2];
#pragma unroll
        for (int bj = 0; bj < 2; ++bj)
#pragma unroll
            for (int n = 0; n < 2; ++n) gv[bj][n] = *(const f32x4*)(gp + bj * HALF + n * 4);
        if constexpr (IN_BF16) {
            v4u bs[2][4][2];
#pragma unroll
            for (int ai = 0; ai < 2; ++ai)
#pragma unroll
                for (int m = 0; m < 4; ++m)
#pragma unroll
                    for (int bj = 0; bj < 2; ++bj) bs[ai][m][bj] = *(const v4u*)((const bf16*)base + (size_t)(row0 + ai * HALF + m * 16) * D + col0 + bj * HALF);
#pragma unroll
            for (int ai = 0; ai < 2; ++ai)
#pragma unroll
                for (int m = 0; m < 4; ++m)
#pragma unroll
                    for (int bj = 0; bj < 2; ++bj) { const size_t e = (size_t)(row0 + ai * HALF + m * 16) * D + col0 + bj * HALF; const v4u t = bs[ai][m][bj];
                        const f32x4 o0 = (f32x4){bflo(t.x), bfhi(t.x), bflo(t.y), bfhi(t.y)} + gv[bj][0] * acc[ai][bj][m][0], o1 = (f32x4){bflo(t.z), bfhi(t.z), bflo(t.w), bfhi(t.w)} + gv[bj][1] * acc[ai][bj][m][1];
                        if constexpr (OUT_BF16) { v4u w; w.x = pk2(o0[0], o0[1]); w.y = pk2(o0[2], o0[3]); w.z = pk2(o1[0], o1[1]); w.w = pk2(o1[2], o1[3]); *(v4u*)((bf16*)out + e) = w; }
                        else { *(f32x4*)((float*)out + e) = o0; *(f32x4*)((float*)out + e + 4) = o1; } }
        } else {
#pragma unroll
            for (int ai = 0; ai < 2; ++ai) {
                f32x4 bs[4][2][2];
#pragma unroll
                for (int m = 0; m < 4; ++m)
#pragma unroll
                    for (int bj = 0; bj < 2; ++bj) { const size_t e = (size_t)(row0 + ai * HALF + m * 16) * D + col0 + bj * HALF;
                        bs[m][bj][0] = *(const f32x4*)((const float*)base + e); bs[m][bj][1] = *(const f32x4*)((const float*)base + e + 4); }
#pragma unroll
                for (int m = 0; m < 4; ++m)
#pragma unroll
                    for (int bj = 0; bj < 2; ++bj) { const size_t e = (size_t)(row0 + ai * HALF + m * 16) * D + col0 + bj * HALF;
                        const f32x4 o0 = bs[m][bj][0] + gv[bj][0] * acc[ai][bj][m][0], o1 = bs[m][bj][1] + gv[bj][1] * acc[ai][bj][m][1];
                        if constexpr (OUT_BF16) { v4u w; w.x = pk2(o0[0], o0[1]); w.y = pk2(o0[2], o0[3]); w.z = pk2(o1[0], o1[1]); w.w = pk2(o1[2], o1[3]); *(v4u*)((bf16*)out + e) = w; }
                        else { *(f32x4*)((float*)out + e) = o0; *(f32x4*)((float*)out + e + 4) = o1; } }
            }
        }
    }
};
template <int CTRL> __device__ __forceinline__ float dpp_ror(float v) { return __builtin_bit_cast(float, __builtin_amdgcn_update_dpp(0, __builtin_bit_cast(int, v), CTRL, 0xf, 0xf, false)); }
struct EpiUp {
    static constexpr bool PERM = true;
    bf16* ACT; bf16* RAW; const float* cw; const float* cb;
    __device__ __forceinline__ void operator()(const Acc& acc, const Unit& u, int wr, int wc, int fr, int fq) const {
#pragma unroll
        for (int n = 0; n < 2; ++n) {
            const int j4 = u.pn * HALF + wc * 32 + 8 * fq + 4 * n;
            const f32x4 wa0 = *(const f32x4*)(cw + j4), wa1 = *(const f32x4*)(cw + NUP + j4), wa2 = *(const f32x4*)(cw + 2 * NUP + j4), ba = *(const f32x4*)(cb + j4);
            const f32x4 wg0 = *(const f32x4*)(cw + FF + j4), wg1 = *(const f32x4*)(cw + NUP + FF + j4), wg2 = *(const f32x4*)(cw + 2 * NUP + FF + j4), bg = *(const f32x4*)(cb + FF + j4);
            const int rawcol = u.pn * BM + wc * 32 + 8 * fq + 4 * n;
#pragma unroll
            for (int ai = 0; ai < 2; ++ai) {
                const int gi = u.pm * 4 + ai * 2 + wr;
                f32x4 pa = (f32x4){0.f, 0.f, 0.f, 0.f}, pg = pa;
#pragma unroll
                for (int m = 0; m < 4; ++m) {
                    const f32x4 ca = acc[ai][0][m][n], cg = acc[ai][1][m][n];
                    f32x4 o;
#pragma unroll
                    for (int e = 0; e < 4; ++e) {
                        const float ta1 = (fr == 15) ? pa[e] : ca[e], ta2 = (fr >= 14) ? pa[e] : ca[e], tg1 = (fr == 15) ? pg[e] : cg[e], tg2 = (fr >= 14) ? pg[e] : cg[e];
                        const float a1 = dpp_ror<0x121>(ta1), a2 = dpp_ror<0x122>(ta2), g1 = dpp_ror<0x121>(tg1), g2 = dpp_ror<0x122>(tg2);
                        const float va = ba[e] + wa0[e] * a2 + wa1[e] * a1 + wa2[e] * ca[e];
                        const float vg = bg[e] + wg0[e] * g2 + wg1[e] * g1 + wg2[e] * cg[e];
                        o[e] = vg * sigmoidf_(vg) * va;
                    }
                    const int row = u.pm * BM + ai * HALF + wr * 64 + m * 16 + fr;
                    if (!(m == 0 && fr < 2)) { v2u w; w.x = pk2a(o[0], o[1]); w.y = pk2a(o[2], o[3]); *(v2u*)(ACT + (size_t)row * FF + j4) = w; }
                    if ((m == 0 && fr < 2) || (m == 3 && fr >= 14)) {
                        const int slot = (m == 0) ? fr : fr - 12;
                        bf16* rp = RAW + ((size_t)gi * 4 + slot) * NUP + rawcol;
                        v2u w; w.x = pk2(ca[0], ca[1]); w.y = pk2(ca[2], ca[3]); *(v2u*)rp = w;
                        w.x = pk2(cg[0], cg[1]); w.y = pk2(cg[2], cg[3]); *(v2u*)(rp + HALF) = w;
                    }
                    pa = ca; pg = cg;
                }
            }
        }
    }
};

template <class Epi, bool ALIGN_EPI = true, bool KEEP = false>
__device__ __forceinline__ void gemm_phase(LAS unsigned char* lds, const Gemm g, const StaticOrder& S, const Epi& E) {
    const int tid = threadIdx.x, wid = __builtin_amdgcn_readfirstlane(tid >> 6), lane = tid & 63, wr = wid >> 2, wc = wid & 3, fr = lane & 15, fq = lane >> 4;
    const int K = g.K, nt = K / BK;
    unsigned voffA[2], voffB[2];
#pragma unroll
    for (int i = 0; i < 2; ++i) { int R, C; stage_rc(tid * 16 + i * 8192, R, C); const int Rb = Epi::PERM ? ((R & ~31) + perm32(R & 31)) : R;
        voffA[i] = (unsigned)(R * K + C) * 2u; voffB[i] = (unsigned)(Rb * K + C) * 2u; }
    const size_t kstep = (size_t)(BK * 2);
    const size_t hstep = (size_t)HALF * K * 2;
    const size_t tstep = 2 * hstep;
    const unsigned ldsw = (unsigned)wid * 1024u;
    const int aoff = lds_byte(wr * 64 + fr, fq * 8), boff = lds_byte(wc * 32 + fr, fq * 8);
#define PG8_SA1(b) ((b) * HTB)
#define PG8_SB(b, h) ((2 + (b) * 2 + (h)) * HTB)
#define PG8_STAGE(bufoff, gbase, voff) do { _Pragma("unroll") for (int _i = 0; _i < 2; ++_i) \
        __builtin_amdgcn_global_load_lds((const unsigned*)((const char*)(gbase) + (voff)[_i]), (LAS unsigned*)(lds + (bufoff) + ldsw + _i * 8192), 16, 0, 0); } while (0)
#define PG8_LDA(dst, off) do { _Pragma("unroll") for (int m = 0; m < 4; ++m) _Pragma("unroll") for (int k = 0; k < 2; ++k) dst[m][k] = *(const LAS bf16x8*)(lds + (off) + aoff + m * 2048 + k * 1024); } while (0)
#define PG8_LDB(dst, b, h) do { _Pragma("unroll") for (int n = 0; n < 2; ++n) _Pragma("unroll") for (int k = 0; k < 2; ++k) dst[n][k] = *(const LAS bf16x8*)(lds + PG8_SB(b, h) + boff + n * 2048 + k * 1024); } while (0)
#define PG8_MMA(ai, bj, At, Bt) do { __builtin_amdgcn_s_setprio(1); _Pragma("unroll") for (int m = 0; m < 4; ++m) _Pragma("unroll") for (int n = 0; n < 2; ++n) _Pragma("unroll") for (int k = 0; k < 2; ++k) \
        acc[ai][bj][m][n] = __builtin_amdgcn_mfma_f32_16x16x32_bf16(Bt[n][k], At[m][k], acc[ai][bj][m][n], 0, 0, 0); __builtin_amdgcn_s_setprio(0); } while (0)
#define PG8_WAIT_V(n) asm volatile("s_waitcnt vmcnt(" #n ")" ::: "memory")
#define PG8_WAIT_L(n) asm volatile("s_waitcnt lgkmcnt(" #n ")" ::: "memory")
#define PG8_BAR __builtin_amdgcn_s_barrier()
#define PG8_SCHED __builtin_amdgcn_sched_barrier(0)
#define PG8_ABASE(u) ((const char*)((u).z ? g.A1 : g.A0) + (size_t)(u).pm * tstep)
#define PG8_BBASE(u) ((const char*)((u).z ? g.B1 : g.B0) + (size_t)(u).pn * tstep)
    Unit cur, nxt; int ui = 0;
    if (!S.next(0, cur)) return;
    Acc acc;
#pragma unroll
    for (int a = 0; a < 2; ++a)
#pragma unroll
        for (int b = 0; b < 2; ++b)
#pragma unroll
            for (int m = 0; m < 4; ++m)
#pragma unroll
                for (int n = 0; n < 2; ++n) acc[a][b][m][n] = (f32x4){0.f, 0.f, 0.f, 0.f};
    bf16x8 At[4][2], B0[2][2], B1[2][2];
    const char* cA = PG8_ABASE(cur); const char* cB = PG8_BBASE(cur);
    int o0 = 6 * HTB, o1 = 7 * HTB, o2 = 8 * HTB;
    PG8_STAGE(PG8_SB(0, 0), cB, voffB); PG8_STAGE(PG8_SB(0, 1), cB + hstep, voffB); PG8_STAGE(o0, cA, voffA); PG8_STAGE(PG8_SA1(0), cA + hstep, voffA);
    if (wr == 1) PG8_BAR;
    PG8_WAIT_V(2); PG8_BAR;
    PG8_STAGE(PG8_SB(1, 0), cB + kstep, voffB); PG8_STAGE(o1, cA + kstep, voffA); PG8_STAGE(PG8_SB(1, 1), cB + hstep + kstep, voffB);
    PG8_WAIT_V(6); PG8_BAR;
    for (;;) {
        const bool has_next = S.next(ui + 1, nxt);
        const char* nA = has_next ? PG8_ABASE(nxt) : cA; const char* nB = has_next ? PG8_BBASE(nxt) : cB;
        for (int t = 0; t < nt; t += 2) {
            const bool last = (t == nt - 2);
            const char* a1 = cA + (size_t)(t + 1) * kstep;
            const char* a2 = last ? nA : cA + (size_t)(t + 2) * kstep; const char* b2 = last ? nB : cB + (size_t)(t + 2) * kstep;
            const char* a3 = a2 + kstep; const char* b3 = b2 + kstep;
            PG8_LDB(B0, 0, 0); PG8_LDB(B1, 0, 1); PG8_SCHED; PG8_LDA(At, o0); PG8_STAGE(PG8_SA1(1), a1 + hstep, voffA); PG8_STAGE(o2, a2, voffA);
            PG8_WAIT_V(10); PG8_WAIT_L(0); PG8_BAR; PG8_MMA(0, 0, At, B0); PG8_MMA(0, 1, At, B1); PG8_BAR; PG8_SCHED;
            PG8_LDA(At, PG8_SA1(0)); PG8_STAGE(PG8_SB(0, 0), b2, voffB); PG8_STAGE(PG8_SB(0, 1), b2 + hstep, voffB);
            PG8_WAIT_V(8); PG8_WAIT_L(0); PG8_BAR; PG8_MMA(1, 0, At, B0); PG8_MMA(1, 1, At, B1); PG8_BAR; PG8_SCHED;
            PG8_LDB(B0, 1, 0); PG8_LDB(B1, 1, 1); PG8_SCHED; PG8_LDA(At, o1); PG8_STAGE(PG8_SA1(0), a2 + hstep, voffA); PG8_STAGE(o0, a3, voffA);
            PG8_WAIT_V(10); PG8_WAIT_L(0); PG8_BAR; PG8_MMA(0, 0, At, B0); PG8_MMA(0, 1, At, B1); PG8_BAR; PG8_SCHED;
            PG8_LDA(At, PG8_SA1(1)); PG8_STAGE(PG8_SB(1, 0), b3, voffB); PG8_STAGE(PG8_SB(1, 1), b3 + hstep, voffB);
            PG8_WAIT_V(8); PG8_WAIT_L(0); PG8_BAR; PG8_MMA(1, 0, At, B0); PG8_MMA(1, 1, At, B1); PG8_BAR; PG8_SCHED;
            { const int t_ = o0; o0 = o2; o2 = o1; o1 = t_; }
        }
        if constexpr (ALIGN_EPI) { if (wr == 0) PG8_BAR; }
        E(acc, cur, wr, wc, fr, fq);
        if (!has_next) break;
        bool zero = true; if constexpr (KEEP) zero = !E.keep(cur);
        if (zero) {
#pragma unroll
        for (int a = 0; a < 2; ++a)
#pragma unroll
            for (int b = 0; b < 2; ++b)
#pragma unroll
                for (int m = 0; m < 4; ++m)
#pragma unroll
                    for (int n = 0; n < 2; ++n) acc[a][b][m][n] = (f32x4){0.f, 0.f, 0.f, 0.f};
        }
        cur = nxt; cA = nA; cB = nB; ++ui;
        if constexpr (ALIGN_EPI) { if (wr == 1) PG8_BAR; }
    }
    PG8_WAIT_V(0);
    if constexpr (!ALIGN_EPI) { if (wr == 0) PG8_BAR; }
    PG8_BAR;
#undef PG8_SA1
#undef PG8_SB
#undef PG8_STAGE
#undef PG8_LDA
#undef PG8_LDB
#undef PG8_MMA
#undef PG8_WAIT_V
#undef PG8_WAIT_L
#undef PG8_BAR
#undef PG8_SCHED
#undef PG8_ABASE
#undef PG8_BBASE
}
}

#define XB_TMO      128
#define XB_XCNT(j)  (256  + 64 * (j))
#define XB_XSUB(j)  (1280 + 64 * (j))
#define XB_XGEN(j)  (2304 + 64 * (j))
#define XB_TOP      3328
#define XB_TOPGEN   3392
#define XCD_BAR_WORDS 3456
#define XB_SPIN_CAP (1u << 18)
__device__ __forceinline__ unsigned xb_ld(unsigned* p)              { return __hip_atomic_load(p, __ATOMIC_RELAXED, __HIP_MEMORY_SCOPE_AGENT); }
__device__ __forceinline__ unsigned xb_add(unsigned* p, unsigned v) { return __hip_atomic_fetch_add(p, v, __ATOMIC_RELAXED, __HIP_MEMORY_SCOPE_AGENT); }
__device__ __forceinline__ unsigned xb_xcc_id() { return (unsigned)__builtin_amdgcn_s_getreg((3 << 11) | 20) & 0xFu; }
#define XB_SPIN(cond, bar) do { unsigned _sp = 0; while (cond) { __builtin_amdgcn_s_sleep(1); \
    if ((++_sp & 255u) == 0u) { if (xb_ld(&(bar)[XB_TMO])) break; if (_sp > XB_SPIN_CAP) { atomicAdd(&(bar)[XB_TMO], 1u); break; } } } } while (0)
struct XcdBarrier { unsigned* bar; unsigned x; volatile LAS unsigned* st; };
__device__ __forceinline__ XcdBarrier xcd_barrier_post(unsigned* bar, volatile LAS unsigned* st) {
    XcdBarrier b; b.bar = bar; b.x = xb_xcc_id(); b.st = st;
    if (threadIdx.x == 0) (void)xb_add(&bar[XB_XCNT(b.x)], 1u);
    return b;
}
__device__ __forceinline__ void xcd_barrier_complete(unsigned* bar, unsigned x, unsigned& nloc, unsigned& nx) {
    const unsigned G = gridDim.x * gridDim.y * gridDim.z;
    unsigned sum, cnt, mine, sp = 0u;
    for (;;) {
        sum = 0u; cnt = 0u; mine = 0u;
#pragma unroll
        for (unsigned j = 0; j < 16; ++j) { const unsigned c = xb_ld(&bar[XB_XCNT(j)]); sum += c; cnt += (c > 0u) ? 1u : 0u; mine = (j == x) ? c : mine; }
        if (sum == G) break;
        __builtin_amdgcn_s_sleep(1);
        if ((++sp & 255u) == 0u) { if (xb_ld(&bar[XB_TMO])) break; if (sp > XB_SPIN_CAP) { atomicAdd(&bar[XB_TMO], 1u); break; } }
    }
    nloc = mine > 0u ? mine : 1u; nx = cnt > 0u ? cnt : 1u;
}
__device__ __forceinline__ void xcd_barrier(const XcdBarrier& b) {
    asm volatile("s_waitcnt vmcnt(0)" ::: "memory");
    __syncthreads();
    if (threadIdx.x == 0) {
        unsigned* bar = b.bar;
        __builtin_amdgcn_s_waitcnt(0);
        unsigned nloc = b.st[0], nx = b.st[1];
        if (nloc == 0u) { xcd_barrier_complete(bar, b.x, nloc, nx); b.st[0] = nloc; b.st[1] = nx; }
        const unsigned old = xb_add(&bar[XB_XSUB(b.x)], 1u);
        const unsigned gen = old / nloc;
        if (old + 1u == (gen + 1u) * nloc) {
            __builtin_amdgcn_fence(__ATOMIC_RELEASE, "agent");
            asm volatile("s_waitcnt vmcnt(0)" ::: "memory");
            const unsigned og = xb_add(&bar[XB_TOP], 1u);
            const unsigned tg = og / nx;
            if (og + 1u == (tg + 1u) * nx) xb_add(&bar[XB_TOPGEN], 1u);
            else XB_SPIN(xb_ld(&bar[XB_TOPGEN]) == tg, bar);
            __builtin_amdgcn_fence(__ATOMIC_ACQUIRE, "agent");
            xb_add(&bar[XB_XGEN(b.x)], 1u);
            asm volatile("s_waitcnt vmcnt(0)" ::: "memory");
        } else {
            XB_SPIN(xb_ld(&bar[XB_XGEN(b.x)]) == gen, bar);
            __builtin_amdgcn_fence(__ATOMIC_ACQUIRE, "agent");
            asm volatile("s_waitcnt vmcnt(0)" ::: "memory");
        }
    }
    __syncthreads();
}

struct Frame {
    LAS unsigned char* lds; volatile LAS unsigned* MISC; gu32* ctl;
    int tid, lane, wave, vcu, G;
};
struct Args { const float* in[29]; float* out; unsigned char* ws; int ph_lo, ph_hi; };

__device__ __forceinline__ void ada_item(Frame& F, int it, const float* cvec, const float* ada_w, const float* ada_b, float* mod) {
    LAS float* cv = (LAS float*)F.lds;
    LAS float* red = (LAS float*)(F.lds + 32768);
    for (int i = F.tid; i < 2 * D; i += NWAVES * 64) cv[i] = cvec[i];
    __syncthreads();
    const int rs = F.lane / 24, cl = F.lane - rs * 24; const bool act = F.lane < 48;
    f32x4 a0 = (f32x4){0.f, 0.f, 0.f, 0.f}, a1 = a0;
    if (act) {
        const float* wp = ada_w + (size_t)(2 * F.wave + rs) * (6 * D) + it * 96 + cl * 4;
#pragma unroll 8
        for (int i = 0; i < D / 16; ++i) { const f32x4 v = *(const f32x4*)(wp + (size_t)i * 16 * (6 * D)); const int k = 16 * i + 2 * F.wave + rs; a0 += cv[k] * v; a1 += cv[D + k] * v; }
    }
#pragma unroll
    for (int e = 0; e < 4; ++e) { a0[e] += __shfl_down(a0[e], 24); a1[e] += __shfl_down(a1[e], 24); }
    if (F.lane < 24) { *(LAS f32x4*)(red + (F.wave * 2 + 0) * 96 + cl * 4) = a0; *(LAS f32x4*)(red + (F.wave * 2 + 1) * 96 + cl * 4) = a1; }
    __syncthreads();
    if (F.tid < 192) { const int b = F.tid / 96, ci = F.tid - b * 96; float s = ada_b[it * 96 + ci];
#pragma unroll
        for (int w = 0; w < 8; ++w) s += red[(w * 2 + b) * 96 + ci];
        mod[b * 6 * D + it * 96 + ci] = s; }
    __syncthreads();
}
__device__ __forceinline__ void p0_transpose_item(const float* W, int K, int N, bf16* WT, bool upmap, LAS float* scr, int item, int lane) {
    const int nblk = N / 32, kb = item / nblk, nb = item - kb * nblk, k0 = 64 * kb, n0 = 32 * nb;
    int d0 = n0; if (upmap) { const int half = n0 >= FF ? 1 : 0, j = n0 - half * FF; d0 = 256 * (j >> 7) + 128 * half + (j & 127); }
    const float* src = W + (size_t)(k0 + (lane >> 5)) * N + n0 + (lane & 31);
    float v[32];
#pragma unroll
    for (int i = 0; i < 32; ++i) v[i] = src[(size_t)(2 * i) * N];
#pragma unroll
    for (int i = 0; i < 32; ++i) scr[(2 * i + (lane >> 5)) * 33 + (lane & 31)] = v[i];
    LDS_WAIT(); asm volatile("" ::: "memory");
    const int c = lane & 7;
#pragma unroll
    for (int j = 0; j < 4; ++j) { const int n = (lane >> 3) + 8 * j; const LAS float* sp = scr + (8 * c) * 33 + n;
        v4u o; o.x = pk2w(sp[0 * 33], sp[1 * 33]); o.y = pk2w(sp[2 * 33], sp[3 * 33]); o.z = pk2w(sp[4 * 33], sp[5 * 33]); o.w = pk2w(sp[6 * 33], sp[7 * 33]);
        *(GAS v4u*)(WT + (size_t)(d0 + n) * K + k0 + 8 * c) = o; }
    LDS_WAIT(); asm volatile("" ::: "memory");
}
struct cplx { double re, im; };
__device__ __forceinline__ void s5_precompute(Frame& F, int g, const Args& a, unsigned char* ws) {
    const float* a_re = a.in[11]; const float* a_im = a.in[12]; const float* b_re = a.in[13]; const float* b_im = a.in[14]; const float* c_re = a.in[15]; const float* c_im = a.in[16]; const float* log_dt = a.in[18];
    LAS f32x2* pw = (LAS f32x2*)F.lds;
    LAS f32x2* bb = (LAS f32x2*)(F.lds + 33280);
    LAS f32x2* cm = (LAS f32x2*)(F.lds + 33280 + 8192);
    if (F.tid < NSTATE) {
        const int p = F.tid;
        const double dt = exp((double)log_dt[g]);
        const double lre = (double)a_re[g * NSTATE + p], lim = (double)a_im[g * NSTATE + p];
        const double ea = exp(lre * dt), th = lim * dt;
        const double are = ea * cos(th), aim = ea * sin(th);
        const double den = lre * lre + lim * lim;
        const double nre = are - 1.0, nim = aim;
        const double cre = (nre * lre + nim * lim) / den, cim = (nim * lre - nre * lim) / den;
        double pr = 1.0, pi = 0.0;
        pw[p] = (f32x2){1.f, 0.f};
        for (int n = 1; n <= TCH; ++n) { const double tr = pr * are - pi * aim, ti = pr * aim + pi * are; pr = tr; pi = ti; pw[n * NSTATE + p] = (f32x2){(float)pr, (float)pi}; }
        ((f32x2*)(ws + WS_A64))[g * NSTATE + p] = (f32x2){(float)pr, (float)pi};
        for (int c = 0; c < SGC; ++c) { const double br = (double)b_re[(g * NSTATE + p) * SGC + c], bi = (double)b_im[(g * NSTATE + p) * SGC + c];
            bb[p * SGC + c] = (f32x2){(float)(cre * br - cim * bi), (float)(cre * bi + cim * br)}; }
    }
    for (int i = F.tid; i < SGC * NSTATE; i += NWAVES * 64) cm[i] = (f32x2){c_re[g * SGC * NSTATE + i], c_im[g * SGC * NSTATE + i]};
    __syncthreads();
    {
        const int half = F.tid >> 8, c = (F.tid >> 4) & 15, c2 = F.tid & 15;
        float kacc[32];
#pragma unroll
        for (int t = 0; t < 32; ++t) kacc[t] = 0.f;
        for (int p = 0; p < NSTATE; ++p) {
            const f32x2 C = cm[c * NSTATE + p], B = bb[p * SGC + c2];
            const float xr = C.x * B.x - C.y * B.y, xi = C.x * B.y + C.y * B.x;
#pragma unroll
            for (int t = 0; t < 32; ++t) { const f32x2 w = pw[(32 * half + t) * NSTATE + p]; kacc[t] += xr * w.x - xi * w.y; }
        }
        bf16* kt = (bf16*)(ws + WS_KTAB) + (size_t)g * (68 * 256);
#pragma unroll
        for (int t = 0; t < 32; ++t) kt[(63 - (32 * half + t)) * 256 + c * 16 + c2] = (bf16)f2bf(kacc[t]);
        kt[(64 + 2 * half) * 256 + c * 16 + c2] = 0; kt[(65 + 2 * half) * 256 + c * 16 + c2] = 0;
    }
    {
        v4u* m2 = (v4u*)(ws + WS_M2) + (size_t)g * 16384;
        for (int vi = F.tid; vi < 16384; vi += NWAVES * 64) {
            const int ln = vi & 63, sp = (vi >> 6) & 31, rb = vi >> 11;
            const int rho = 16 * rb + (ln & 15), p = rho >> 1, ri = rho & 1, s = 2 * sp + (ln >> 5), cb = 8 * ((ln >> 4) & 1);
            const f32x2 w = pw[(TCH - 1 - s) * NSTATE + p]; float v[8];
#pragma unroll
            for (int i = 0; i < 8; ++i) { const f32x2 B = bb[p * SGC + cb + i]; v[i] = ri ? (w.x * B.y + w.y * B.x) : (w.x * B.x - w.y * B.y); }
            v4u o; o.x = pk2(v[0], v[1]); o.y = pk2(v[2], v[3]); o.z = pk2(v[4], v[5]); o.w = pk2(v[6], v[7]); m2[vi] = o;
        }
    }
    {
        v4u* m3 = (v4u*)(ws + WS_M3) + (size_t)g * 16384;
        for (int vi = F.tid; vi < 16384; vi += NWAVES * 64) {
            const int ln = vi & 63, ks = (vi >> 6) & 3, r = vi >> 8;
            const int c = ln & 15, rho0 = 32 * ks + 8 * (ln >> 4); float v[8];
#pragma unroll
            for (int i = 0; i < 8; ++i) { const int rho = rho0 + i, p = rho >> 1, ri = rho & 1; const f32x2 C = cm[c * NSTATE + p], w = pw[(r + 1) * NSTATE + p];
                v[i] = ri ? -(C.x * w.y + C.y * w.x) : (C.x * w.x - C.y * w.y); }
            v4u o; o.x = pk2(v[0], v[1]); o.y = pk2(v[2], v[3]); o.z = pk2(v[4], v[5]); o.w = pk2(v[6], v[7]); m3[vi] = o;
        }
    }
    __syncthreads();
}

__device__ __forceinline__ void adanorm_rows(Frame& F, const float* X, bf16* H, const float* gain, const float* mod, int sh_off, int sc_off) {
    const int gw = F.vcu * NWAVES + F.wave, NGW = F.G * NWAVES;
    for (int m = gw; m < M; m += NGW) {
        const GAS f32x4* xr = (const GAS f32x4*)(X + (size_t)m * D) + F.lane;
        f32x4 v[16]; float ss = 0.f;
#pragma unroll
        for (int j = 0; j < 16; ++j) { v[j] = xr[64 * j]; ss += (v[j].x * v[j].x + v[j].y * v[j].y) + (v[j].z * v[j].z + v[j].w * v[j].w); }
        const float rstd = 1.0f / sqrtf(wave_sum(ss) * (1.f / D) + EPS);
        const float* mb = mod + (m >= SEQ ? 6 * D : 0);
        GAS v2u* o8 = (GAS v2u*)(H + (size_t)m * D) + F.lane;
#pragma unroll
        for (int j = 0; j < 16; ++j) { const int col = 4 * (F.lane + 64 * j);
            const f32x4 gn = *(const f32x4*)(gain + col), sc = *(const f32x4*)(mb + sc_off + col), sh = *(const f32x4*)(mb + sh_off + col);
            const f32x4 y = v[j] * rstd * gn * (sc + 1.0f) + sh;
            v2u w; w.x = pk2a(y.x, y.y); w.y = pk2a(y.z, y.w); o8[64 * j] = w; }
    }
}
__device__ __forceinline__ void adanorm_rows_bf16(Frame& F, const bf16* X, bf16* H, const float* gain, const float* mod, int sh_off, int sc_off) {
    const int gw = F.vcu * NWAVES + F.wave, NGW = F.G * NWAVES;
    for (int m = gw; m < M; m += NGW) {
        const GAS v4u* xr = (const GAS v4u*)(X + (size_t)m * D) + F.lane;
        v4u v[8]; float ss = 0.f;
#pragma unroll
        for (int j = 0; j < 8; ++j) { v[j] = xr[64 * j];
            ss += (bflo(v[j].x) * bflo(v[j].x) + bfhi(v[j].x) * bfhi(v[j].x)) + (bflo(v[j].y) * bflo(v[j].y) + bfhi(v[j].y) * bfhi(v[j].y)) + (bflo(v[j].z) * bflo(v[j].z) + bfhi(v[j].z) * bfhi(v[j].z)) + (bflo(v[j].w) * bflo(v[j].w) + bfhi(v[j].w) * bfhi(v[j].w)); }
        const float rstd = 1.0f / sqrtf(wave_sum(ss) * (1.f / D) + EPS);
        const float* mb = mod + (m >= SEQ ? 6 * D : 0);
        GAS v4u* o16 = (GAS v4u*)(H + (size_t)m * D) + F.lane;
#pragma unroll
        for (int j = 0; j < 8; ++j) { const int col = 8 * (F.lane + 64 * j);
            const f32x4 g0 = *(const f32x4*)(gain + col), g1 = *(const f32x4*)(gain + col + 4), c0 = *(const f32x4*)(mb + sc_off + col), c1 = *(const f32x4*)(mb + sc_off + col + 4), h0 = *(const f32x4*)(mb + sh_off + col), h1 = *(const f32x4*)(mb + sh_off + col + 4);
            const f32x4 x0 = (f32x4){bflo(v[j].x), bfhi(v[j].x), bflo(v[j].y), bfhi(v[j].y)}, x1 = (f32x4){bflo(v[j].z), bfhi(v[j].z), bflo(v[j].w), bfhi(v[j].w)};
            const f32x4 y0 = x0 * rstd * g0 * (c0 + 1.0f) + h0, y1 = x1 * rstd * g1 * (c1 + 1.0f) + h1;
            v4u w; w.x = pk2a(y0[0], y0[1]); w.y = pk2a(y0[2], y0[3]); w.z = pk2a(y1[0], y1[1]); w.w = pk2a(y1[2], y1[3]); o16[64 * j] = w; }
    }
}
__device__ __forceinline__ void final_norm_rows(Frame& F, const bf16* X, float* O, const float* gain) {
    const int gw = F.vcu * NWAVES + F.wave, NGW = F.G * NWAVES;
    for (int m = gw; m < M; m += NGW) {
        const GAS v4u* xr = (const GAS v4u*)(X + (size_t)m * D) + F.lane;
        v4u v[8]; float ss = 0.f;
#pragma unroll
        for (int j = 0; j < 8; ++j) { v[j] = xr[64 * j];
            ss += (bflo(v[j].x) * bflo(v[j].x) + bfhi(v[j].x) * bfhi(v[j].x)) + (bflo(v[j].y) * bflo(v[j].y) + bfhi(v[j].y) * bfhi(v[j].y)) + (bflo(v[j].z) * bflo(v[j].z) + bfhi(v[j].z) * bfhi(v[j].z)) + (bflo(v[j].w) * bflo(v[j].w) + bfhi(v[j].w) * bfhi(v[j].w)); }
        const float rstd = 1.0f / sqrtf(wave_sum(ss) * (1.f / D) + EPS);
        GAS f32x4* o = (GAS f32x4*)(O + (size_t)m * D) + 2 * F.lane;
#pragma unroll
        for (int j = 0; j < 8; ++j) { const int col = 8 * (F.lane + 64 * j); const f32x4 g0 = *(const f32x4*)(gain + col), g1 = *(const f32x4*)(gain + col + 4);
            o[128 * j] = (f32x4){bflo(v[j].x), bfhi(v[j].x), bflo(v[j].y), bfhi(v[j].y)} * rstd * g0; o[128 * j + 1] = (f32x4){bflo(v[j].z), bfhi(v[j].z), bflo(v[j].w), bfhi(v[j].w)} * rstd * g1; }
    }
}

__device__ __forceinline__ float gelu_tanh(float y) { const float t = 0.7978845608028654f * (y + 0.044715f * y * y * y); return y * __builtin_amdgcn_rcpf(1.0f + __builtin_amdgcn_exp2f(-2.0f * LOG2E * t)); }
__device__ __forceinline__ void s5_unit(Frame& F, int g, int b, const bf16* U, bf16* Z, const unsigned char* ws, const float* dskip) {
    constexpr int KT_BYTES = 68 * 512, M3_OFF = KT_BYTES, SB_OFF = KT_BYTES + 32768;
    LAS unsigned char* lds = F.lds;
    LAS float* SB = (LAS float*)(lds + SB_OFF);
    const int lane = F.lane, w = F.wave, j = lane & 15, lg = lane >> 4, tid = F.tid;
    const unsigned tok0 = (unsigned)b * SEQ + (unsigned)(16 * w + j) * TCH;
    const unsigned uoff = ((tok0 + (lg >> 1)) * QK_PITCH + g * SGC + 8 * (lg & 1)) * 2u;
    bf16x8 uf[32];
#pragma unroll
    for (int sp = 0; sp < 32; ++sp) uf[sp] = *(const bf16x8*)((const char*)U + (uoff + (unsigned)(2 * sp) * QK_PITCH * 2u));
    {
        const v4u* m2g = (const v4u*)(ws + WS_M2) + (size_t)g * 16384;
        v4u st[4];
#pragma unroll
        for (int i = 0; i < 4; ++i) st[i] = m2g[tid + 512 * i];
#pragma unroll
        for (int i = 0; i < 4; ++i) *(LAS v4u*)(lds + (tid + 512 * i) * 16) = st[i];
        __syncthreads();
#pragma unroll 1
        for (int rb = 0; rb < 8; ++rb) {
            if (rb + 1 < 8) {
#pragma unroll
                for (int i = 0; i < 4; ++i) st[i] = m2g[(rb + 1) * 2048 + tid + 512 * i]; }
            const LAS unsigned char* mb = lds + (rb & 1) * 32768 + lane * 16;
            f32x4 acc = (f32x4){0.f, 0.f, 0.f, 0.f};
#pragma unroll
            for (int sp = 0; sp < 32; ++sp) acc = __builtin_amdgcn_mfma_f32_16x16x32_bf16(*(const LAS bf16x8*)(mb + sp * 1024), uf[sp], acc, 0, 0, 0);
            *(LAS f32x4*)(SB + (16 * w + j) * 128 + 16 * rb + 4 * lg) = acc;
            if (rb + 1 < 8) {
#pragma unroll
                for (int i = 0; i < 4; ++i) *(LAS v4u*)(lds + ((rb + 1) & 1) * 32768 + (tid + 512 * i) * 16) = st[i]; }
            __syncthreads();
        }
    }
    const v4u* m3g = (const v4u*)(ws + WS_M3) + (size_t)g * 16384;
    { const v4u* src = (const v4u*)(ws + WS_KTAB + (size_t)g * KT_BYTES); for (int i = tid; i < KT_BYTES / 16; i += NWAVES * 64) *(LAS v4u*)(lds + i * 16) = src[i];
#pragma unroll
      for (int i = 0; i < 2; ++i) *(LAS v4u*)(lds + M3_OFF + (tid + 512 * i) * 16) = m3g[tid + 512 * i]; }
    if (w == 0) {
        const f32x2 a = ((const f32x2*)(ws + WS_A64))[g * NSTATE + lane];
        float xr = 0.f, xi = 0.f;
        for (int c = 0; c < NCH; ++c) { LAS f32x2* sp = (LAS f32x2*)(SB + c * 128) + lane; const f32x2 s = *sp; *sp = (f32x2){xr, xi};
            const float nr = a.x * xr - a.y * xi + s.x, ni = a.x * xi + a.y * xr + s.y; xr = nr; xi = ni; }
    }
    __syncthreads();
    LAS unsigned char* xfb = (LAS unsigned char*)(SB + 16 * w * 128) + lane * 16;
    { v4u t[4];
#pragma unroll
      for (int ks = 0; ks < 4; ++ks) { const LAS f32x4* xp = (const LAS f32x4*)(SB + (16 * w + j) * 128 + 32 * ks + 8 * lg); const f32x4 x0 = xp[0], x1 = xp[1];
          t[ks].x = pk2(x0[0], x0[1]); t[ks].y = pk2(x0[2], x0[3]); t[ks].z = pk2(x1[0], x1[1]); t[ks].w = pk2(x1[2], x1[3]); }
      asm volatile("s_waitcnt lgkmcnt(0)" : "+v"(t[0]), "+v"(t[1]), "+v"(t[2]), "+v"(t[3]) :: "memory");
#pragma unroll
      for (int ks = 0; ks < 4; ++ks) *(LAS v4u*)(xfb + ks * 1024) = t[ks]; }
    const f32x4 dsk = *(const f32x4*)(dskip + g * SGC + 4 * lg);
    const int klane = (60 + (lg >> 1)) * 512 + (lane & 15) * 32 + 16 * (lg & 1);
#pragma unroll 1
    for (int R = 0; R < 16; ++R) {
        v4u st2[2];
        if (R + 1 < 16) {
#pragma unroll
            for (int i = 0; i < 2; ++i) st2[i] = m3g[(R + 1) * 1024 + tid + 512 * i]; }
        const LAS unsigned char* m3b = lds + M3_OFF + (R & 1) * 16384 + lane * 16;
        const LAS unsigned char* kp = lds + (klane - 2048 * R);
        f32x4 acc[4];
#pragma unroll
        for (int r = 0; r < 4; ++r) { acc[r] = (f32x4){0.f, 0.f, 0.f, 0.f};
#pragma unroll
            for (int ks = 0; ks < 4; ++ks) acc[r] = __builtin_amdgcn_mfma_f32_16x16x32_bf16(*(const LAS bf16x8*)(m3b + (r * 4 + ks) * 1024), *(const LAS bf16x8*)(xfb + ks * 1024), acc[r], 0, 0, 0); }
#pragma unroll
        for (int sp = 0; sp < 32; ++sp) {
            if (2 * sp <= 4 * R + 3) {
#pragma unroll
                for (int r = 0; r < 4; ++r) { const bf16x8 kf = *(const LAS bf16x8*)(kp + (2 * sp - r + 3) * 512);
                    acc[r] = __builtin_amdgcn_mfma_f32_16x16x32_bf16(kf, uf[sp], acc[r], 0, 0, 0); }
            }
        }
#pragma unroll
        for (int r = 0; r < 4; ++r) {
            const unsigned tok = tok0 + 4 * R + r;
            const v2u uu = *(const v2u*)((const char*)U + (tok * QK_PITCH + g * SGC + 4 * lg) * 2u);
            const float y0 = acc[r][0] + dsk[0] * bflo(uu.x), y1 = acc[r][1] + dsk[1] * bfhi(uu.x), y2 = acc[r][2] + dsk[2] * bflo(uu.y), y3 = acc[r][3] + dsk[3] * bfhi(uu.y);
            v2u o; o.x = pk2a(gelu_tanh(y0), gelu_tanh(y1)); o.y = pk2a(gelu_tanh(y2), gelu_tanh(y3));
            *(v2u*)((char*)Z + (tok * SW + g * SGC + 4 * lg) * 2u) = o;
        }
        if (R + 1 < 16) {
#pragma unroll
            for (int i = 0; i < 2; ++i) *(LAS v4u*)(lds + M3_OFF + ((R + 1) & 1) * 16384 + (tid + 512 * i) * 16) = st2[i]; }
        __syncthreads();
    }
}

__device__ __forceinline__ void kmax_task(Frame& F, const bf16* QKVU, unsigned* kmaxw) {
    LAS float* red = (LAS float*)F.lds;
    for (int blk = F.vcu; blk < M / 64; blk += F.G) {
        float mx[4] = {0.f, 0.f, 0.f, 0.f};
        for (int tt = 0; tt < 8; ++tt) {
            const v4u* kp = (const v4u*)(QKVU + (size_t)(blk * 64 + F.wave * 8 + tt) * QK_PITCH + 2048);
#pragma unroll
            for (int i = 0; i < 4; ++i) { const v4u c = kp[F.lane + 64 * i];
                float sq = bflo(c.x) * bflo(c.x) + bfhi(c.x) * bfhi(c.x) + bflo(c.y) * bflo(c.y) + bfhi(c.y) * bfhi(c.y) + bflo(c.z) * bflo(c.z) + bfhi(c.z) * bfhi(c.z) + bflo(c.w) * bflo(c.w) + bfhi(c.w) * bfhi(c.w);
                sq += __shfl_xor(sq, 1); sq += __shfl_xor(sq, 2); sq += __shfl_xor(sq, 4);
                mx[i] = fmaxf(mx[i], sq); }
        }
        if ((F.lane & 7) == 0) {
#pragma unroll
            for (int i = 0; i < 4; ++i) red[F.wave * 32 + (F.lane >> 3) + 8 * i] = mx[i]; }
        __syncthreads();
        if (F.tid < 32) { float m = red[F.tid];
#pragma unroll
            for (int w = 1; w < 8; ++w) m = fmaxf(m, red[w * 32 + F.tid]);
            atomicMax(kmaxw + (blk >= (SEQ / 64) ? 32 : 0) + F.tid, __builtin_bit_cast(unsigned, m)); }
        __syncthreads();
    }
}

namespace att {
constexpr float THR_SKIP = 32.f;
constexpr float THR_RESC = 6.f;
__device__ __forceinline__ unsigned off_b(unsigned row, unsigned ch) { return 256u * row + 16u * (ch ^ (((row & 3) << 2) | ((row >> 2) & 3))); }
__device__ __forceinline__ int crow(int r, int hi) { return (r & 3) + 8 * (r >> 2) + 4 * hi; }
__device__ __forceinline__ void glds16(const void* gsrc, unsigned lds_dst) { unsigned keep;
    asm volatile("s_mov_b32 %0, m0\n\ts_mov_b32 m0, %2\n\ts_nop 0\n\tglobal_load_lds_dwordx4 %1, off\n\ts_mov_b32 m0, %0" : "=&s"(keep) : "v"(gsrc), "s"(lds_dst) : "memory"); }
__device__ __forceinline__ void attn_unit(Frame& F, int b, int h, int qb, const bf16* QKVU, bf16* ATT, float lam, const float* subln_g, const unsigned* kmaxw) {
    LAS unsigned char* lds = F.lds;
    LAS unsigned* flg = (LAS unsigned*)(lds + 98304);
    const int tid = F.tid, lane = F.lane, wid = F.wave, jh = wid >> 2, qg = wid & 3, r32 = lane & 31, hi = lane >> 5;
    const int q0 = qb * 128, qw0 = q0 + 32 * qg; const size_t rowbase = (size_t)b * SEQ;
    const float slope2 = __builtin_amdgcn_exp2f(-0.5f * (float)(h + 1)) * LOG2E;
    bf16x8 qr[4];
    { const bf16* Qp = QKVU + (rowbase + qw0 + r32) * QK_PITCH + h * 128 + jh * 64 + hi * 8;
#pragma unroll
      for (int d0 = 0; d0 < 4; ++d0) qr[d0] = *(const bf16x8*)(Qp + d0 * 16); }
    float cbound;
    { float qn2 = 0.f;
#pragma unroll
      for (int d0 = 0; d0 < 4; ++d0)
#pragma unroll
          for (int e = 0; e < 8; ++e) { const float v = __builtin_bit_cast(float, (unsigned)(unsigned short)qr[d0][e] << 16); qn2 += v * v; }
      qn2 += __shfl_xor(qn2, 32);
      cbound = sqrtf(qn2 * __builtin_bit_cast(float, kmaxw[b * 32 + h * 2 + jh])) * 1.002f + 0.05f; }
    const int NT = (q0 + 128) / 64;
    const char* kbase = (const char*)(QKVU + rowbase * QK_PITCH + 2048 + h * 128);
    const unsigned lds0 = (unsigned)(uintptr_t)lds;
    unsigned koffs[2];
#pragma unroll
    for (int i = 0; i < 2; ++i) { const unsigned row = 4u * (2 * wid + i) + (lane >> 4), ch = (lane & 15) ^ (((row & 3) << 2) | ((row >> 2) & 3)); koffs[i] = (row * QK_PITCH + ch * 8) * 2u; }
#define ATT_DMA(tile, slot) do { const char* kt_ = kbase + (size_t)(tile) * (64 * QK_PITCH * 2); const unsigned sb_ = lds0 + (unsigned)(slot) * 32768u + (unsigned)wid * 2048u; \
        glds16(kt_ + koffs[0], sb_); glds16(kt_ + koffs[1], sb_ + 1024u); glds16(kt_ + 4096 + koffs[0], sb_ + 16384u); glds16(kt_ + 4096 + koffs[1], sb_ + 16384u + 1024u); } while (0)
    ATT_DMA(NT - 1, 0); ATT_DMA(NT - 2, 1);
    unsigned koff[4];
#pragma unroll
    for (int d0 = 0; d0 < 4; ++d0) koff[d0] = off_b(r32, jh * 8 + 2 * d0 + hi);
    unsigned vb[4][2];
    { const unsigned q4 = (lane & 15) >> 2, b16 = (lane >> 4) & 1, p4 = lane & 3;
#pragma unroll
      for (int c = 0; c < 4; ++c)
#pragma unroll
          for (int tt = 0; tt < 2; ++tt) vb[c][tt] = off_b(8 * tt + 4 * hi + q4, 4 * c + 2 * b16 + (p4 >> 1)) + 8 * (p4 & 1); }
    float ab[16];
#pragma unroll
    for (int r = 0; r < 16; ++r) ab[r] = slope2 * (float)crow(r, hi);
    f32x16 o[4];
#pragma unroll
    for (int c = 0; c < 4; ++c)
#pragma unroll
        for (int r = 0; r < 16; ++r) o[c][r] = 0.f;
    float m_run = 0.f, l_sum = 0.f;
    bool started = false, wdone = false;
    int slot = 0;
    for (int t = NT - 1; t >= 0; --t) {
        if (t > 0) asm volatile("s_waitcnt vmcnt(4)" ::: "memory"); else asm volatile("s_waitcnt vmcnt(0)" ::: "memory");
        __builtin_amdgcn_s_barrier(); asm volatile("" ::: "memory");
        if (t < NT - 1) { const v4u f0 = *(const LAS v4u*)(flg + ((t + 1) & 1) * 8), f1 = *(const LAS v4u*)(flg + ((t + 1) & 1) * 8 + 4);
            if ((f0.x & f0.y & f0.z & f0.w & f1.x & f1.y & f1.z & f1.w) != 0u) break; }
        if (t >= 2) { const int s2 = slot >= 1 ? slot - 1 : 2; ATT_DMA(t - 2, s2); }
        const int kv0 = 64 * t;
        if (!wdone && kv0 <= qw0 + 31) {
            const LAS unsigned char* Kb = lds + slot * 32768; const LAS unsigned char* Vb = Kb + 16384;
            f32x16 p0, p1;
            { const float base = slope2 * (float)(kv0 - q0) - m_run;
#pragma unroll
              for (int r = 0; r < 16; ++r) { p0[r] = ab[r] + base; p1[r] = p0[r] + 32.f * slope2; } }
            __builtin_amdgcn_s_setprio(1);
#pragma unroll
            for (int d0 = 0; d0 < 4; ++d0) { const bf16x8 k0 = *(const LAS bf16x8*)(Kb + koff[d0]), k1 = *(const LAS bf16x8*)(Kb + 8192 + koff[d0]);
                p0 = __builtin_amdgcn_mfma_f32_32x32x16_bf16(k0, qr[d0], p0, 0, 0, 0); p1 = __builtin_amdgcn_mfma_f32_32x32x16_bf16(k1, qr[d0], p1, 0, 0, 0); }
            __builtin_amdgcn_s_setprio(0);
            if (kv0 + 63 > qw0) { const int qpos = qw0 + r32;
#pragma unroll
                for (int r = 0; r < 16; ++r) { const int kv = kv0 + crow(r, hi); if (kv > qpos) p0[r] = -INFINITY; if (kv + 32 > qpos) p1[r] = -INFINITY; } }
            float mx = fmaxf(fmaxf(p0[0], p0[1]), p1[0]), mx2 = fmaxf(fmaxf(p0[2], p0[3]), p1[1]);
            mx = fmaxf(fmaxf(mx, p1[2]), p1[3]);
#pragma unroll
            for (int r = 4; r < 16; r += 4) { mx = fmaxf(fmaxf(mx, p0[r]), p0[r + 1]); mx2 = fmaxf(fmaxf(mx2, p0[r + 2]), p0[r + 3]); mx = fmaxf(fmaxf(mx, p1[r]), p1[r + 1]); mx2 = fmaxf(fmaxf(mx2, p1[r + 2]), p1[r + 3]); }
            mx = fmaxf(mx, mx2);
            mx = fmaxf(mx, __shfl_xor(mx, 32));
            bool sub = false; float delta = 0.f;
            if (!started) { delta = mx; started = true; sub = true; }
            else if (__any(mx > THR_RESC)) { delta = fmaxf(mx, 0.f); sub = true; const float f = __builtin_amdgcn_exp2f(-delta); l_sum *= f;
#pragma unroll
                for (int c = 0; c < 4; ++c)
#pragma unroll
                    for (int r = 0; r < 16; ++r) o[c][r] *= f; }
            if (sub) { m_run += delta;
#pragma unroll
                for (int r = 0; r < 16; ++r) { p0[r] -= delta; p1[r] -= delta; } }
            float ls = 0.f, ls2 = 0.f;
#pragma unroll
            for (int r = 0; r < 16; ++r) { p0[r] = __builtin_amdgcn_exp2f(p0[r]); p1[r] = __builtin_amdgcn_exp2f(p1[r]); ls += p0[r]; ls2 += p1[r]; }
            l_sum += ls + ls2;
            bf16x8 pf[2][2];
#pragma unroll
            for (int s = 0; s < 2; ++s) { v4u a, c;
                a.x = pk2(p0[8 * s + 0], p0[8 * s + 1]); a.y = pk2(p0[8 * s + 2], p0[8 * s + 3]); a.z = pk2(p0[8 * s + 4], p0[8 * s + 5]); a.w = pk2(p0[8 * s + 6], p0[8 * s + 7]);
                c.x = pk2(p1[8 * s + 0], p1[8 * s + 1]); c.y = pk2(p1[8 * s + 2], p1[8 * s + 3]); c.z = pk2(p1[8 * s + 4], p1[8 * s + 5]); c.w = pk2(p1[8 * s + 6], p1[8 * s + 7]);
                pf[0][s] = __builtin_bit_cast(bf16x8, a); pf[1][s] = __builtin_bit_cast(bf16x8, c); }
            __builtin_amdgcn_s_setprio(1);
#pragma unroll
            for (int c = 0; c < 4; ++c) {
                const LAS unsigned char* vp0 = Vb + vb[c][0]; const LAS unsigned char* vp1 = Vb + vb[c][1];
#pragma unroll
                for (int blk = 0; blk < 2; ++blk)
#pragma unroll
                    for (int s = 0; s < 2; ++s) {
                        const s16x4 v0 = __builtin_bit_cast(s16x4, __builtin_amdgcn_ds_read_tr16_b64_v4i16((LAS s16x4*)(vp0 + 8192 * blk + 4096 * s)));
                        const s16x4 v1 = __builtin_bit_cast(s16x4, __builtin_amdgcn_ds_read_tr16_b64_v4i16((LAS s16x4*)(vp1 + 8192 * blk + 4096 * s)));
                        const bf16x8 vf = (bf16x8){v0[0], v0[1], v0[2], v0[3], v1[0], v1[1], v1[2], v1[3]};
                        o[c] = __builtin_amdgcn_mfma_f32_32x32x16_bf16(vf, pf[blk][s], o[c], 0, 0, 0);
                    }
            }
            __builtin_amdgcn_s_setprio(0);
            wdone = __all(cbound + slope2 * (float)(kv0 - 1 - q0) - m_run < -THR_SKIP);
        }
        if (lane == 0) flg[(t & 1) * 8 + wid] = wdone ? 1u : 0u;
        asm volatile("s_waitcnt lgkmcnt(0)" ::: "memory");
        slot = slot == 2 ? 0 : slot + 1;
    }
#undef ATT_DMA
    asm volatile("s_waitcnt vmcnt(0)" ::: "memory");
    __syncthreads();
    l_sum += __shfl_xor(l_sum, 32);
    const float inv = 1.0f / l_sum;
    LAS float* cmb = (LAS float*)lds;
    if (jh == 1) {
#pragma unroll
        for (int c = 0; c < 4; ++c)
#pragma unroll
            for (int r = 0; r < 16; ++r) cmb[(qg * 64 + c * 16 + r) * 64 + lane] = o[c][r] * inv;
    }
    __syncthreads();
    if (jh == 0) {
        float ss = 0.f;
#pragma unroll
        for (int c = 0; c < 4; ++c)
#pragma unroll
            for (int r = 0; r < 16; ++r) { const float v = o[c][r] * inv - lam * cmb[(qg * 64 + c * 16 + r) * 64 + lane]; o[c][r] = v; ss += v * v; }
        ss += __shfl_xor(ss, 32);
        const float rs = (1.0f / sqrtf(ss * (1.f / 128.f) + EPS)) * (1.0f - LAM_INIT);
        bf16* op = ATT + (rowbase + qw0 + r32) * AW + h * 128;
#pragma unroll
        for (int c = 0; c < 4; ++c)
#pragma unroll
            for (int k = 0; k < 4; ++k) { const int dv = 32 * c + 8 * k + 4 * hi; const f32x4 gg = *(const f32x4*)(subln_g + dv);
                v2u w; w.x = pk2a(o[c][4 * k + 0] * rs * gg[0], o[c][4 * k + 1] * rs * gg[1]); w.y = pk2a(o[c][4 * k + 2] * rs * gg[2], o[c][4 * k + 3] * rs * gg[3]);
                *(v2u*)(op + dv) = w; }
    }
    __syncthreads();
}
}

__device__ __forceinline__ void conv_fixup(Frame& F, const bf16* RAW, bf16* ACT, const float* cw, const float* cb) {
    const int gt = F.vcu * (NWAVES * 64) + F.tid, NT = F.G * NWAVES * 64;
    constexpr int C4 = FF / 4;
    for (int it = gt; it < 256 * C4; it += NT) {
        const int gi = it / C4, j4 = (it - gi * C4) * 4;
        const int na = 256 * (j4 >> 7) + (j4 & 127);
        const bool first = (gi & 127) == 0;
        f32x4 a[4], g[4];
#pragma unroll
        for (int k = 0; k < 4; ++k) {
            if (k < 2 && first) { a[k] = (f32x4){0.f, 0.f, 0.f, 0.f}; g[k] = a[k]; continue; }
            const bf16* rp = RAW + ((size_t)(k < 2 ? gi - 1 : gi) * 4 + (k < 2 ? k + 2 : k - 2)) * NUP + na;
            const v2u ua = *(const v2u*)rp, ug = *(const v2u*)(rp + 128);
            a[k] = (f32x4){bflo(ua.x), bfhi(ua.x), bflo(ua.y), bfhi(ua.y)}; g[k] = (f32x4){bflo(ug.x), bfhi(ug.x), bflo(ug.y), bfhi(ug.y)};
        }
        const f32x4 wa0 = *(const f32x4*)(cw + j4), wa1 = *(const f32x4*)(cw + NUP + j4), wa2 = *(const f32x4*)(cw + 2 * NUP + j4), ba = *(const f32x4*)(cb + j4);
        const f32x4 wg0 = *(const f32x4*)(cw + FF + j4), wg1 = *(const f32x4*)(cw + NUP + FF + j4), wg2 = *(const f32x4*)(cw + 2 * NUP + FF + j4), bg = *(const f32x4*)(cb + FF + j4);
#pragma unroll
        for (int r = 0; r < 2; ++r) {
            const f32x4 va = ba + wa0 * a[r] + wa1 * a[r + 1] + wa2 * a[r + 2], vg = bg + wg0 * g[r] + wg1 * g[r + 1] + wg2 * g[r + 2];
            v2u w; w.x = pk2a(vg[0] * sigmoidf_(vg[0]) * va[0], vg[1] * sigmoidf_(vg[1]) * va[1]); w.y = pk2a(vg[2] * sigmoidf_(vg[2]) * va[2], vg[3] * sigmoidf_(vg[3]) * va[3]);
            *(v2u*)(ACT + (size_t)(gi * 64 + r) * FF + j4) = w;
        }
    }
}

constexpr int NPH = 13;
__global__ void __launch_bounds__(NWAVES * 64, 2) fwd_kernel(Args args) {
    extern __shared__ __attribute__((aligned(16))) unsigned char lds[];
    Frame F;
    F.lds = (LAS unsigned char*)lds; F.MISC = (volatile LAS unsigned*)(F.lds + MISC_OFF);
    F.tid = threadIdx.x; F.lane = F.tid & 63; F.wave = __builtin_amdgcn_readfirstlane(F.tid >> 6);
    F.G = gridDim.x; { const int bx = blockIdx.x; F.vcu = (F.G % 8 == 0) ? (bx % 8) * (F.G / 8) + bx / 8 : bx; }
    unsigned char* ws = args.ws; F.ctl = (gu32*)(ws + WS_CTL);
    for (int u = F.tid; u < (LDS_BYTES - LDSCTL_OFF) / 4; u += NWAVES * 64) ((LAS unsigned*)(F.lds + LDSCTL_OFF))[u] = 0u;
    __syncthreads();
    XcdBarrier bar; bar.bar = (unsigned*)(F.ctl + CW_BAR); bar.x = 0; bar.st = nullptr;
    if (!MK_PER_PHASE) bar = xcd_barrier_post((unsigned*)(F.ctl + CW_BAR), F.MISC + 8);
    const int lo = args.ph_lo, hi = args.ph_hi;
#ifndef PH_MASK
#define PH_MASK 0x1fff
#endif
#define IN(k) (((PH_MASK >> (k)) & 1) && lo <= (k) && (k) < hi)
#define SEAM(k) do { if (IN(k) && IN((k) + 1)) xcd_barrier(bar); } while (0)
    const float* x = args.in[0]; float* out = args.out;
    float* mod = (float*)(ws + WS_MOD);
    bf16* WIN = (bf16*)(ws + WS_WIN); bf16* WGLU = (bf16*)(ws + WS_WGLU); bf16* WA = (bf16*)(ws + WS_WA); bf16* WS_ = (bf16*)(ws + WS_WS); bf16* WOUT = (bf16*)(ws + WS_WOUT);
    bf16* WUP = (bf16*)(ws + WS_WUP); bf16* WDN = (bf16*)(ws + WS_WDN);
    bf16* H = (bf16*)(ws + WS_H); bf16* QKVU = (bf16*)(ws + WS_QKVU); bf16* GATES = (bf16*)(ws + WS_GATES); bf16* ACT = (bf16*)(ws + WS_ACT);
    bf16* ATT = (bf16*)(ws + WS_ATT); bf16* Z = (bf16*)(ws + WS_Z); bf16* SSM = (bf16*)(ws + WS_SSM); bf16* RAW = (bf16*)(ws + WS_RAW);
    bf16* X1 = (bf16*)(ws + WS_WIN);

    if (IN(0)) {
        for (int it = F.vcu; it < 256; it += F.G) ada_item(F, it, args.in[1], args.in[2], args.in[3], mod);
        for (int g = F.vcu; g < NGRP; g += F.G) s5_precompute(F, g, args, ws);
        LAS float* scr = (LAS float*)(F.lds + F.wave * 16384);
        const int gw = F.vcu * NWAVES + F.wave, NGW = F.G * NWAVES;
        constexpr int I_IN = (D / 64) * (NIN / 32), I_GLU = (SW / 64) * (SW / 32), I_A = (AW / 64) * (D / 32), I_S = (SW / 64) * (D / 32), I_OUT = (D / 64) * (D / 32), I_UP = (D / 64) * (NUP / 32), I_DN = (FF / 64) * (D / 32);
        constexpr int NITEMS = I_IN + I_GLU + I_A + I_S + I_OUT + I_UP + I_DN;
        for (;;) {
            unsigned base = 0;
            if (F.lane == 0) base = __hip_atomic_fetch_add((unsigned*)(F.ctl + CW_QT0), 8u, __ATOMIC_RELAXED, __HIP_MEMORY_SCOPE_AGENT);
            base = (unsigned)__builtin_amdgcn_readfirstlane((int)base);
            if (base >= (unsigned)NITEMS) break;
            for (int it = (int)base; it < (int)base + 8 && it < NITEMS; ++it) {
                int r = it;
                if (r < I_IN) { p0_transpose_item(args.in[5], D, NIN, WIN, false, scr, r, F.lane); continue; } r -= I_IN;
                if (r < I_GLU) { p0_transpose_item(args.in[19], SW, SW, WGLU, false, scr, r, F.lane); continue; } r -= I_GLU;
                if (r < I_A) { p0_transpose_item(args.in[20], AW, D, WA, false, scr, r, F.lane); continue; } r -= I_A;
                if (r < I_S) { p0_transpose_item(args.in[21], SW, D, WS_, false, scr, r, F.lane); continue; } r -= I_S;
                if (r < I_OUT) { p0_transpose_item(args.in[22], D, D, WOUT, false, scr, r, F.lane); continue; } r -= I_OUT;
                if (r < I_UP) { p0_transpose_item(args.in[24], D, NUP, WUP, true, scr, r, F.lane); continue; } r -= I_UP;
                p0_transpose_item(args.in[27], FF, D, WDN, false, scr, r, F.lane);
            }
        }
    }
    SEAM(0);
    if (IN(1)) adanorm_rows(F, x, H, args.in[4], mod, 0, D);
    SEAM(1);
    if (IN(2)) {
        pg8::Gemm g{H, WIN, H, WIN, M, NIN, D}; pg8::StaticOrder S; S.init(M, NIN, F.G, (int)blockIdx.x, 0);
        pg8::EpiInProj E{QKVU, GATES, 0.125f * LOG2E};
        pg8::gemm_phase<pg8::EpiInProj>(F.lds, g, S, E);
    }
    SEAM(2);
    if (IN(3)) { kmax_task(F, QKVU, (unsigned*)(F.ctl + CW_KMAX));
        for (int u = F.vcu; u < 2 * NGRP; u += F.G) s5_unit(F, u >> 1, u & 1, QKVU + 6144, Z, ws, args.in[17]); }
    SEAM(3);
    if (IN(4)) {
        float lam; { const float v1 = args.in[6][F.lane] * args.in[7][F.lane], v2 = args.in[8][F.lane] * args.in[9][F.lane]; lam = expf(wave_sum(v1)) - expf(wave_sum(v2)) + LAM_INIT; }
        for (;;) {
            if (F.tid == 0) F.MISC[16] = __hip_atomic_fetch_add((unsigned*)(F.ctl + CW_QATT), 1u, __ATOMIC_RELAXED, __HIP_MEMORY_SCOPE_AGENT);
            __syncthreads();
            const unsigned u = F.MISC[16];
            if (u >= 2048u) break;
            const int hh = 15 - (int)(u >> 7), rem = (int)(u & 127);
            att::attn_unit(F, rem & 1, hh, 63 - (rem >> 1), QKVU, ATT, lam, args.in[10], (const unsigned*)(F.ctl + CW_KMAX));
        }
    }
    SEAM(4);
    if (IN(5)) {
        pg8::Gemm g{Z, WGLU, Z, WGLU, M, SW, SW}; pg8::StaticOrder S; S.init(M, SW, F.G, (int)blockIdx.x, 0);
        pg8::EpiGlu E{Z, SSM};
        pg8::gemm_phase<pg8::EpiGlu>(F.lds, g, S, E);
    }
    SEAM(5);
    if (IN(6)) {
        pg8::Gemm g{ATT, WA, SSM, WS_, M, D, AW}; pg8::StaticOrder S; S.init(M, D, F.G, (int)blockIdx.x, 1);
        pg8::EpiMerge E{GATES, H};
        pg8::gemm_phase<pg8::EpiMerge, true, true>(F.lds, g, S, E);
    }
    SEAM(6);
    if (IN(7)) {
        pg8::Gemm g{H, WOUT, H, WOUT, M, D, D}; pg8::StaticOrder S; S.init(M, D, F.G, (int)blockIdx.x, 0);
        pg8::EpiResid<false, true> E{x, X1, mod + 2 * D};
        pg8::gemm_phase<pg8::EpiResid<false, true>>(F.lds, g, S, E);
    }
    SEAM(7);
    if (IN(8)) adanorm_rows_bf16(F, X1, H, args.in[23], mod, 3 * D, 4 * D);
    SEAM(8);
    if (IN(9)) {
        pg8::Gemm g{H, WUP, H, WUP, M, NUP, D}; pg8::StaticOrder S; S.init(M, NUP, F.G, (int)blockIdx.x, 0);
        pg8::EpiUp E{ACT, RAW, args.in[25], args.in[26]};
        pg8::gemm_phase<pg8::EpiUp>(F.lds, g, S, E);
    }
    SEAM(9);
    if (IN(10)) conv_fixup(F, RAW, ACT, args.in[25], args.in[26]);
    SEAM(10);
    if (IN(11)) {
        pg8::Gemm g{ACT, WDN, ACT, WDN, M, D, FF}; pg8::StaticOrder S; S.init(M, D, F.G, (int)blockIdx.x, 0);
        pg8::EpiResid<true, true> E{X1, H, mod + 5 * D};
        pg8::gemm_phase<pg8::EpiResid<true, true>>(F.lds, g, S, E);
    }
    SEAM(11);
    if (IN(12)) final_norm_rows(F, H, out, args.in[28]);
#undef IN
#undef SEAM
}

extern "C" void kernel_launch(void* const* d_in, const int* in_sizes, int n_in, void* d_out, int out_size, void* d_ws, size_t ws_size, hipStream_t stream) {
    static int grid = 0;
    if (grid == 0) {
        if (n_in != 29 || in_sizes[0] != M * D || out_size != M * D || ws_size < WS_END) { fprintf(stderr, "kernel_launch: unexpected shapes (n_in %d, in0 %d, out %d, ws %zu)\n", n_in, n_in > 0 ? in_sizes[0] : -1, out_size, ws_size); grid = -1; return; }
        int dev = 0, cus = 0, per_cu = 0;
        if (hipGetDevice(&dev) != hipSuccess || hipDeviceGetAttribute(&cus, hipDeviceAttributeMultiprocessorCount, dev) != hipSuccess) { grid = -1; return; }
        if (hipFuncSetAttribute((const void*)fwd_kernel, hipFuncAttributeMaxDynamicSharedMemorySize, LDS_BYTES) != hipSuccess) { fprintf(stderr, "kernel_launch: hipFuncSetAttribute failed\n"); grid = -1; return; }
        if (hipOccupancyMaxActiveBlocksPerMultiprocessor(&per_cu, (const void*)fwd_kernel, NWAVES * 64, LDS_BYTES) != hipSuccess || per_cu < 1) fprintf(stderr, "kernel_launch: occupancy query says %d\n", per_cu);
        (void)hipGetLastError();
        grid = cus;
    }
    if (grid < 0) return;
    (void)hipMemsetAsync((char*)d_ws + WS_CTL, 0, CTL_ZERO_BYTES, stream);
    Args a{};
    for (int i = 0; i < 29; ++i) a.in[i] = (const float*)d_in[i];
    a.out = (float*)d_out; a.ws = (unsigned char*)d_ws;
#if MK_PER_PHASE
    for (int p = 0; p < NPH; ++p) { a.ph_lo = p; a.ph_hi = p + 1; hipLaunchKernelGGL(fwd_kernel, dim3(grid), dim3(NWAVES * 64), LDS_BYTES, stream, a); }
#else
    a.ph_lo = 0; a.ph_hi = NPH; hipLaunchKernelGGL(fwd_kernel, dim3(grid), dim3(NWAVES * 64), LDS_BYTES, stream, a);
#endif
}
```

```cpp
#include <hip/hip_runtime.h>
#include <cstdio>
#include <cstdint>

#ifndef MK_PER_PHASE
#define MK_PER_PHASE 0
#endif

#define GAS __attribute__((address_space(1)))
#define LAS __attribute__((address_space(3)))
typedef unsigned short bf16;
typedef unsigned v4u __attribute__((ext_vector_type(4)));
typedef unsigned v2u __attribute__((ext_vector_type(2)));
typedef float f32x2 __attribute__((ext_vector_type(2)));
typedef float f32x4 __attribute__((ext_vector_type(4)));
typedef float f32x16 __attribute__((ext_vector_type(16)));
typedef short bf16x8 __attribute__((ext_vector_type(8)));
typedef short s16x4 __attribute__((ext_vector_type(4)));
typedef GAS unsigned gu32;

constexpr int BATCH = 2, SEQ = 8192, M = BATCH * SEQ, D = 4096;
constexpr int NHEAD = 16, AW = 2048, SW = 2048, NIN = 16384, FF = 11008, NUP = 2 * FF;
constexpr int NGRP = 128, SGC = 16, NSTATE = 64, TCH = 64, NCH = SEQ / TCH;
constexpr float EPS = 1e-6f, LAM_INIT = 0.2f;
constexpr float LOG2E = 1.4426950408889634f;
constexpr int QK_PITCH = 8192;

constexpr size_t MiB = 1u << 20;
constexpr size_t WS_CTL = 0, CTL_ZERO_BYTES = 64 * 1024;
constexpr size_t WS_WIN = 1 * MiB;
constexpr size_t WS_Z = 1 * MiB, WS_SSM = 65 * MiB;
constexpr size_t WS_WGLU = 129 * MiB, WS_WA = 137 * MiB, WS_WS = 153 * MiB, WS_WOUT = 169 * MiB, WS_WUP = 201 * MiB, WS_WDN = 373 * MiB;
constexpr size_t WS_H = 459 * MiB;
constexpr size_t WS_QKVU = 587 * MiB, WS_GATES = 843 * MiB;
constexpr size_t WS_ACT = 587 * MiB;
constexpr size_t WS_ATT = 1099 * MiB;
constexpr size_t WS_RAW = 1163 * MiB;
constexpr size_t WS_M2 = 1206 * MiB, WS_M3 = 1238 * MiB;
constexpr size_t WS_KTAB = 1270 * MiB;
constexpr size_t WS_MOD = 1275 * MiB;
constexpr size_t WS_A64 = WS_MOD + 256 * 1024;
constexpr size_t WS_END = 1276 * MiB;
constexpr int CW_TMO = 0, CW_BAR = 4096, CW_QATT = 8192, CW_QT0 = 8256, CW_KMAX = 12288;

constexpr int RING_BYTES = 147456, LDS_BYTES = RING_BYTES + 1024, LDSCTL_OFF = RING_BYTES, MISC_OFF = LDSCTL_OFF + 320;
constexpr int NWAVES = 8;

__device__ __forceinline__ unsigned f2bf(float f) { unsigned u = __builtin_bit_cast(unsigned, f); return (u + 0x7fffu + ((u >> 16) & 1u)) >> 16; }
__device__ __forceinline__ unsigned pk2(float lo, float hi) { unsigned r; asm("v_cvt_pk_bf16_f32 %0, %1, %2" : "=v"(r) : "v"(lo), "v"(hi)); return r; }
__device__ __forceinline__ float bflo(unsigned w) { return __builtin_bit_cast(float, w << 16); }
__device__ __forceinline__ float bfhi(unsigned w) { return __builtin_bit_cast(float, w & 0xffff0000u); }
__device__ __forceinline__ float sigmoidf_(float x) { return __builtin_amdgcn_rcpf(1.0f + __builtin_amdgcn_exp2f(-x * LOG2E)); }
__device__ __forceinline__ float wave_sum(float v) {
#pragma unroll
    for (int o = 1; o < 64; o <<= 1) v += __shfl_xor(v, o);
    return v;
}
#define LDS_WAIT() asm volatile("s_waitcnt lgkmcnt(0)" ::: "memory")
#ifndef WBITS
#define WBITS 5
#endif
#ifndef ABITS
#define ABITS 6
#endif
__device__ __forceinline__ unsigned pk2a(float lo, float hi) {
    constexpr unsigned SH = 16 + (7 - ABITS);
    if (ABITS >= 7) return pk2(lo, hi);
    const unsigned a = (__builtin_bit_cast(unsigned, lo) + (1u << (SH - 1))) & ~((1u << SH) - 1u), b = (__builtin_bit_cast(unsigned, hi) + (1u << (SH - 1))) & ~((1u << SH) - 1u);
    return (a >> 16) | (b & 0xffff0000u);
}
__device__ __forceinline__ unsigned pk2w(float lo, float hi) {
    constexpr unsigned SH = 16 + (7 - WBITS), HALF_ = (1u << (SH - 1)) - 1u;
    unsigned a = __builtin_bit_cast(unsigned, lo), b = __builtin_bit_cast(unsigned, hi);
    a = ((a + HALF_ + ((a >> SH) & 1u)) >> SH) << (SH - 16); b = ((b + HALF_ + ((b >> SH) & 1u)) >> SH) << (SH - 16);
    return (a & 0xffffu) | (b << 16);
}

namespace pg8 {
constexpr int BM = 256, BK = 64, HALF = 128, HTB = HALF * BK * 2, STAGE_BYTES = 8 * HTB, NXCD = 8, WGM = 8;
__host__ __device__ __forceinline__ int lds_byte(int r, int c) { const int st = (r >> 4) * 2 + (c >> 5), rr = r & 15, cc = c & 31, ob = rr * 64 + cc * 2; return st * 1024 + (ob ^ (((ob >> 9) & 1) << 5)); }
__host__ __device__ __forceinline__ void stage_rc(int b, int& R, int& C) { const int st = b / 1024, sb = b % 1024, swz = sb ^ (((sb >> 9) & 1) << 5); R = (st >> 1) * 16 + swz / 64; C = (st & 1) * 32 + (swz % 64) / 2; }
__host__ __device__ __forceinline__ int perm32(int rho) { const int n = rho >> 4, i = rho & 15; return 8 * (i >> 2) + 4 * n + (i & 3); }

struct Unit { int pm, pn, z; };
struct Gemm { const bf16* A0; const bf16* B0; const bf16* A1; const bf16* B1; int M, N, K; };

struct StaticOrder {
    int nM, nN, nwg, G, c, dsh;
    __device__ void init(int M_, int N_, int G_, int c_, int dsh_) { nM = M_ / BM; nN = N_ / BM; nwg = nM * nN; G = G_; c = c_; dsh = dsh_; }
    __device__ bool next(int i, Unit& u) const {
        const int ii = i >> dsh; u.z = i & ((1 << dsh) - 1);
        const long L = (long)ii * G + c; if (L >= nwg) return false;
        int wgid = (int)L; { const int q = nwg / NXCD, r = nwg % NXCD, xcd = wgid % NXCD, off = wgid / NXCD; wgid = (xcd < r ? xcd * (q + 1) : r * (q + 1) + (xcd - r) * q) + off; }
        const int nig = WGM * nN, gid = wgid / nig, fm = gid * WGM, gsz = (nM - fm) < WGM ? (nM - fm) : WGM;
        u.pm = fm + ((wgid % nig) % gsz); u.pn = (wgid % nig) / gsz; return true;
    }
};

typedef f32x4 Acc[2][2][4][2];

struct EpiInProj {
    static constexpr bool PERM = true;
    bf16* QKVU; bf16* GATES; float qscale;
    __device__ __forceinline__ void operator()(const Acc& acc, const Unit& u, int wr, int wc, int fr, int fq) const {
        const int row0 = u.pm * BM + wr * 64 + fr; const bool gate = u.pn >= 32;
        bf16* base = gate ? GATES : QKVU; const int col0 = (gate ? u.pn - 32 : u.pn) * BM + wc * 32 + 8 * fq;
        const float sc = (u.pn < 8) ? qscale : 1.f;
#pragma unroll
        for (int ai = 0; ai < 2; ++ai)
#pragma unroll
            for (int m = 0; m < 4; ++m) { bf16* rowp = base + (size_t)(row0 + ai * HALF + m * 16) * QK_PITCH + col0;
#pragma unroll
                for (int bj = 0; bj < 2; ++bj) { f32x4 v0 = acc[ai][bj][m][0], v1 = acc[ai][bj][m][1];
                    if (gate) { v0 = (f32x4){sigmoidf_(v0[0]), sigmoidf_(v0[1]), sigmoidf_(v0[2]), sigmoidf_(v0[3])}; v1 = (f32x4){sigmoidf_(v1[0]), sigmoidf_(v1[1]), sigmoidf_(v1[2]), sigmoidf_(v1[3])}; }
                    else { v0 = v0 * sc; v1 = v1 * sc; }
                    v4u w; w.x = pk2(v0[0], v0[1]); w.y = pk2(v0[2], v0[3]); w.z = pk2(v1[0], v1[1]); w.w = pk2(v1[2], v1[3]);
                    *(v4u*)(rowp + bj * HALF) = w; } }
    }
};
struct EpiGlu {
    static constexpr bool PERM = true;
    const bf16* Z; bf16* O;
    __device__ __forceinline__ void operator()(const Acc& acc, const Unit& u, int wr, int wc, int fr, int fq) const {
        const int row0 = u.pm * BM + wr * 64 + fr, col0 = u.pn * BM + wc * 32 + 8 * fq;
        v4u zz[2][4][2];
#pragma unroll
        for (int ai = 0; ai < 2; ++ai)
#pragma unroll
            for (int m = 0; m < 4; ++m)
#pragma unroll
                for (int bj = 0; bj < 2; ++bj) zz[ai][m][bj] = *(const v4u*)(Z + (size_t)(row0 + ai * HALF + m * 16) * SW + col0 + bj * HALF);
#pragma unroll
        for (int ai = 0; ai < 2; ++ai)
#pragma unroll
            for (int m = 0; m < 4; ++m)
#pragma unroll
                for (int bj = 0; bj < 2; ++bj) { const f32x4 v0 = acc[ai][bj][m][0], v1 = acc[ai][bj][m][1]; const v4u z4 = zz[ai][m][bj];
                    v4u w; w.x = pk2a(bflo(z4.x) * sigmoidf_(v0[0]), bfhi(z4.x) * sigmoidf_(v0[1])); w.y = pk2a(bflo(z4.y) * sigmoidf_(v0[2]), bfhi(z4.y) * sigmoidf_(v0[3]));
                    w.z = pk2a(bflo(z4.z) * sigmoidf_(v1[0]), bfhi(z4.z) * sigmoidf_(v1[1])); w.w = pk2a(bflo(z4.w) * sigmoidf_(v1[2]), bfhi(z4.w) * sigmoidf_(v1[3]));
                    *(v4u*)(O + (size_t)(row0 + ai * HALF + m * 16) * SW + col0 + bj * HALF) = w; }
    }
};
struct EpiMerge {
    static constexpr bool PERM = true;
    const bf16* GATES; bf16* MG;
    __device__ __forceinline__ void operator()(const Acc& acc, const Unit& u, int wr, int wc, int fr, int fq) const {
        const int row0 = u.pm * BM + wr * 64 + fr, col0 = u.pn * BM + wc * 32 + 8 * fq;
        if (u.z == 0) {
            v4u gg[2][4][2];
#pragma unroll
            for (int ai = 0; ai < 2; ++ai)
#pragma unroll
                for (int m = 0; m < 4; ++m)
#pragma unroll
                    for (int bj = 0; bj < 2; ++bj) gg[ai][m][bj] = *(const v4u*)(GATES + (size_t)(row0 + ai * HALF + m * 16) * QK_PITCH + col0 + bj * HALF);
#pragma unroll
            for (int ai = 0; ai < 2; ++ai)
#pragma unroll
                for (int m = 0; m < 4; ++m)
#pragma unroll
                    for (int bj = 0; bj < 2; ++bj) { const f32x4 v0 = acc[ai][bj][m][0], v1 = acc[ai][bj][m][1]; const v4u g4 = gg[ai][m][bj];
                        v4u w; w.x = pk2a(bflo(g4.x) * v0[0], bfhi(g4.x) * v0[1]); w.y = pk2a(bflo(g4.y) * v0[2], bfhi(g4.y) * v0[3]); w.z = pk2a(bflo(g4.z) * v1[0], bfhi(g4.z) * v1[1]); w.w = pk2a(bflo(g4.w) * v1[2], bfhi(g4.w) * v1[3]);
                        *(v4u*)(MG + (size_t)(row0 + ai * HALF + m * 16) * D + col0 + bj * HALF) = w; }
        } else {
#pragma unroll
            for (int ai = 0; ai < 2; ++ai) {
                v4u gg[4][2], pp[4][2];
#pragma unroll
                for (int m = 0; m < 4; ++m)
#pragma unroll
                    for (int bj = 0; bj < 2; ++bj) { const size_t r = (size_t)(row0 + ai * HALF + m * 16);
                        gg[m][bj] = *(const v4u*)(GATES + r * QK_PITCH + D + col0 + bj * HALF);
                        pp[m][bj] = *(const v4u*)(MG + r * D + col0 + bj * HALF); }
#pragma unroll
                for (int m = 0; m < 4; ++m)
#pragma unroll
                    for (int bj = 0; bj < 2; ++bj) { const size_t r = (size_t)(row0 + ai * HALF + m * 16); const f32x4 v0 = acc[ai][bj][m][0], v1 = acc[ai][bj][m][1]; const v4u g4 = gg[m][bj], p4 = pp[m][bj];
                        v4u w; w.x = pk2a(bflo(p4.x) + bflo(g4.x) * v0[0], bfhi(p4.x) + bfhi(g4.x) * v0[1]); w.y = pk2a(bflo(p4.y) + bflo(g4.y) * v0[2], bfhi(p4.y) + bfhi(g4.y) * v0[3]);
                        w.z = pk2a(bflo(p4.z) + bflo(g4.z) * v1[0], bfhi(p4.z) + bfhi(g4.z) * v1[1]); w.w = pk2a(bflo(p4.w) + bflo(g4.w) * v1[2], bfhi(p4.w) + bfhi(g4.w) * v1[3]);
                        *(v4u*)(MG + r * D + col0 + bj * HALF) = w; }
            }
        }
    }
};
template <bool IN_BF16, bool OUT_BF16>
struct EpiResid {
    static constexpr bool PERM = true;
    const void* base; void* out; const float* gate;
    __device__ __forceinline__ void operator()(const Acc& acc, const Unit& u, int wr, int wc, int fr, int fq) const {
        const int row0 = u.pm * BM + wr * 64 + fr, col0 = u.pn * BM + wc * 32 + 8 * fq; const float* gp = gate + (u.pm >= (SEQ / BM) ? 6 * D : 0) + col0;
        f32x4 gv[2][2];
#pragma unroll
        for (int bj = 0; bj < 2; ++bj)
#pragma unroll
            for (int n = 0; n < 2; ++n) gv[bj][n] = *(const f32x4*)(gp + bj * HALF + n * 4);
        if constexpr (IN_BF16) {
            v4u bs[2][4][2];
#pragma unroll
            for (int ai = 0; ai < 2; ++ai)
#pragma unroll
                for (int m = 0; m < 4; ++m)
#pragma unroll
                    for (int bj = 0; bj < 2; ++bj) bs[ai][m][bj] = *(const v4u*)((const bf16*)base + (size_t)(row0 + ai * HALF + m * 16) * D + col0 + bj * HALF);
#pragma unroll
            for (int ai = 0; ai < 2; ++ai)
#pragma unroll
                for (int m = 0; m < 4; ++m)
#pragma unroll
                    for (int bj = 0; bj < 2; ++bj) { const size_t e = (size_t)(row0 + ai * HALF + m * 16) * D + col0 + bj * HALF; const v4u t = bs[ai][m][bj];
                        const f32x4 o0 = (f32x4){bflo(t.x), bfhi(t.x), bflo(t.y), bfhi(t.y)} + gv[bj][0] * acc[ai][bj][m][0], o1 = (f32x4){bflo(t.z), bfhi(t.z), bflo(t.w), bfhi(t.w)} + gv[bj][1] * acc[ai][bj][m][1];
                        if constexpr (OUT_BF16) { v4u w; w.x = pk2(o0[0], o0[1]); w.y = pk2(o0[2], o0[3]); w.z = pk2(o1[0], o1[1]); w.w = pk2(o1[2], o1[3]); *(v4u*)((bf16*)out + e) = w; }
                        else { *(f32x4*)((float*)out + e) = o0; *(f32x4*)((float*)out + e + 4) = o1; } }
        } else {
#pragma unroll
            for (int ai = 0; ai < 2; ++ai) {
                f32x4 bs[4][2][2];
#pragma unroll
                for (int m = 0; m < 4; ++m)
#pragma unroll
                    for (int bj = 0; bj < 2; ++bj) { const size_t e = (size_t)(row0 + ai * HALF + m * 16) * D + col0 + bj * HALF;
                        bs[m][bj][0] = *(const f32x4*)((const float*)base + e); bs[m][bj][1] = *(const f32x4*)((const float*)base + e + 4); }
#pragma unroll
                for (int m = 0; m < 4; ++m)
#pragma unroll
                    for (int bj = 0; bj < 2; ++bj) { const size_t e = (size_t)(row0 + ai * HALF + m * 16) * D + col0 + bj * HALF;
                        const f32x4 o0 = bs[m][bj][0] + gv[bj][0] * acc[ai][bj][m][0], o1 = bs[m][bj][1] + gv[bj][1] * acc[ai][bj][m][1];
                        if constexpr (OUT_BF16) { v4u w; w.x = pk2(o0[0], o0[1]); w.y = pk2(o0[2], o0[3]); w.z = pk2(o1[0], o1[1]); w.w = pk2(o1[2], o1[3]); *(v4u*)((bf16*)out + e) = w; }
                        else { *(f32x4*)((float*)out + e) = o0; *(f32x4*)((float*)out + e + 4) = o1; } }
            }
        }
    }
};
template <int CTRL> __device__ __forceinline__ float dpp_ror(float v) { return __builtin_bit_cast(float, __builtin_amdgcn_update_dpp(0, __builtin_bit_cast(int, v), CTRL, 0xf, 0xf, false)); }
struct EpiUp {
    static constexpr bool PERM = true;
    bf16* ACT; bf16* RAW; const float* cw; const float* cb;
    __device__ __forceinline__ void operator()(const Acc& acc, const Unit& u, int wr, int wc, int fr, int fq) const {
#pragma unroll
        for (int n = 0; n < 2; ++n) {
            const int j4 = u.pn * HALF + wc * 32 + 8 * fq + 4 * n;
            const f32x4 wa0 = *(const f32x4*)(cw + j4), wa1 = *(const f32x4*)(cw + NUP + j4), wa2 = *(const f32x4*)(cw + 2 * NUP + j4), ba = *(const f32x4*)(cb + j4);
            const f32x4 wg0 = *(const f32x4*)(cw + FF + j4), wg1 = *(const f32x4*)(cw + NUP + FF + j4), wg2 = *(const f32x4*)(cw + 2 * NUP + FF + j4), bg = *(const f32x4*)(cb + FF + j4);
            const int rawcol = u.pn * BM + wc * 32 + 8 * fq + 4 * n;
#pragma unroll
            for (int ai = 0; ai < 2; ++ai) {
                const int gi = u.pm * 4 + ai * 2 + wr;
                f32x4 pa = (f32x4){0.f, 0.f, 0.f, 0.f}, pg = pa;
#pragma unroll
                for (int m = 0; m < 4; ++m) {
                    const f32x4 ca = acc[ai][0][m][n], cg = acc[ai][1][m][n];
                    f32x4 o;
#pragma unroll
                    for (int e = 0; e < 4; ++e) {
                        const float ta1 = (fr == 15) ? pa[e] : ca[e], ta2 = (fr >= 14) ? pa[e] : ca[e], tg1 = (fr == 15) ? pg[e] : cg[e], tg2 = (fr >= 14) ? pg[e] : cg[e];
                        const float a1 = dpp_ror<0x121>(ta1), a2 = dpp_ror<0x122>(ta2), g1 = dpp_ror<0x121>(tg1), g2 = dpp_ror<0x122>(tg2);
                        const float va = ba[e] + wa0[e] * a2 + wa1[e] * a1 + wa2[e] * ca[e];
                        const float vg = bg[e] + wg0[e] * g2 + wg1[e] * g1 + wg2[e] * cg[e];
                        o[e] = vg * sigmoidf_(vg) * va;
                    }
                    const int row = u.pm * BM + ai * HALF + wr * 64 + m * 16 + fr;
                    if (!(m == 0 && fr < 2)) { v2u w; w.x = pk2a(o[0], o[1]); w.y = pk2a(o[2], o[3]); *(v2u*)(ACT + (size_t)row * FF + j4) = w; }
                    if ((m == 0 && fr < 2) || (m == 3 && fr >= 14)) {
                        const int slot = (m == 0) ? fr : fr - 12;
                        bf16* rp = RAW + ((size_t)gi * 4 + slot) * NUP + rawcol;
                        v2u w; w.x = pk2(ca[0], ca[1]); w.y = pk2(ca[2], ca[3]); *(v2u*)rp = w;
                        w.x = pk2(cg[0], cg[1]); w.y = pk2(cg[2], cg[3]); *(v2u*)(rp + HALF) = w;
                    }
                    pa = ca; pg = cg;
                }
            }
        }
    }
};

template <class Epi, bool ALIGN_EPI = true>
__device__ __forceinline__ void gemm_phase(LAS unsigned char* lds, const Gemm g, const StaticOrder& S, const Epi& E) {
    const int tid = threadIdx.x, wid = __builtin_amdgcn_readfirstlane(tid >> 6), lane = tid & 63, wr = wid >> 2, wc = wid & 3, fr = lane & 15, fq = lane >> 4;
    const int K = g.K, nt = K / BK;
    unsigned voffA[2], voffB[2];
#pragma unroll
    for (int i = 0; i < 2; ++i) { int R, C; stage_rc(tid * 16 + i * 8192, R, C); const int Rb = Epi::PERM ? ((R & ~31) + perm32(R & 31)) : R;
        voffA[i] = (unsigned)(R * K + C) * 2u; voffB[i] = (unsigned)(Rb * K + C) * 2u; }
    const size_t kstep = (size_t)(BK * 2);
    const size_t hstep = (size_t)HALF * K * 2;
    const size_t tstep = 2 * hstep;
    const unsigned ldsw = (unsigned)wid * 1024u;
    const int aoff = lds_byte(wr * 64 + fr, fq * 8), boff = lds_byte(wc * 32 + fr, fq * 8);
#define PG8_SA1(b) ((b) * HTB)
#define PG8_SB(b, h) ((2 + (b) * 2 + (h)) * HTB)
#define PG8_STAGE(bufoff, gbase, voff) do { _Pragma("unroll") for (int _i = 0; _i < 2; ++_i) \
        __builtin_amdgcn_global_load_lds((const unsigned*)((const char*)(gbase) + (voff)[_i]), (LAS unsigned*)(lds + (bufoff) + ldsw + _i * 8192), 16, 0, 0); } while (0)
#define PG8_LDA(dst, off) do { _Pragma("unroll") for (int m = 0; m < 4; ++m) _Pragma("unroll") for (int k = 0; k < 2; ++k) dst[m][k] = *(const LAS bf16x8*)(lds + (off) + aoff + m * 2048 + k * 1024); } while (0)
#define PG8_LDB(dst, b, h) do { _Pragma("unroll") for (int n = 0; n < 2; ++n) _Pragma("unroll") for (int k = 0; k < 2; ++k) dst[n][k] = *(const LAS bf16x8*)(lds + PG8_SB(b, h) + boff + n * 2048 + k * 1024); } while (0)
#define PG8_MMA(ai, bj, At, Bt) do { __builtin_amdgcn_s_setprio(1); _Pragma("unroll") for (int m = 0; m < 4; ++m) _Pragma("unroll") for (int n = 0; n < 2; ++n) _Pragma("unroll") for (int k = 0; k < 2; ++k) \
        acc[ai][bj][m][n] = __builtin_amdgcn_mfma_f32_16x16x32_bf16(Bt[n][k], At[m][k], acc[ai][bj][m][n], 0, 0, 0); __builtin_amdgcn_s_setprio(0); } while (0)
#define PG8_WAIT_V(n) asm volatile("s_waitcnt vmcnt(" #n ")" ::: "memory")
#define PG8_WAIT_L(n) asm volatile("s_waitcnt lgkmcnt(" #n ")" ::: "memory")
#define PG8_BAR __builtin_amdgcn_s_barrier()
#define PG8_SCHED __builtin_amdgcn_sched_barrier(0)
#define PG8_ABASE(u) ((const char*)((u).z ? g.A1 : g.A0) + (size_t)(u).pm * tstep)
#define PG8_BBASE(u) ((const char*)((u).z ? g.B1 : g.B0) + (size_t)(u).pn * tstep)
    Unit cur, nxt; int ui = 0;
    if (!S.next(0, cur)) return;
    Acc acc;
#pragma unroll
    for (int a = 0; a < 2; ++a)
#pragma unroll
        for (int b = 0; b < 2; ++b)
#pragma unroll
            for (int m = 0; m < 4; ++m)
#pragma unroll
                for (int n = 0; n < 2; ++n) acc[a][b][m][n] = (f32x4){0.f, 0.f, 0.f, 0.f};
    bf16x8 At[4][2], B0[2][2], B1[2][2];
    const char* cA = PG8_ABASE(cur); const char* cB = PG8_BBASE(cur);
    int o0 = 6 * HTB, o1 = 7 * HTB, o2 = 8 * HTB;
    PG8_STAGE(PG8_SB(0, 0), cB, voffB); PG8_STAGE(PG8_SB(0, 1), cB + hstep, voffB); PG8_STAGE(o0, cA, voffA); PG8_STAGE(PG8_SA1(0), cA + hstep, voffA);
    if (wr == 1) PG8_BAR;
    PG8_WAIT_V(2); PG8_BAR;
    PG8_STAGE(PG8_SB(1, 0), cB + kstep, voffB); PG8_STAGE(o1, cA + kstep, voffA); PG8_STAGE(PG8_SB(1, 1), cB + hstep + kstep, voffB);
    PG8_WAIT_V(6); PG8_BAR;
    for (;;) {
        const bool has_next = S.next(ui + 1, nxt);
        const char* nA = has_next ? PG8_ABASE(nxt) : cA; const char* nB = has_next ? PG8_BBASE(nxt) : cB;
        for (int t = 0; t < nt; t += 2) {
            const bool last = (t == nt - 2);
            const char* a1 = cA + (size_t)(t + 1) * kstep;
            const char* a2 = last ? nA : cA + (size_t)(t + 2) * kstep; const char* b2 = last ? nB : cB + (size_t)(t + 2) * kstep;
            const char* a3 = a2 + kstep; const char* b3 = b2 + kstep;
            PG8_LDB(B0, 0, 0); PG8_LDB(B1, 0, 1); PG8_SCHED; PG8_LDA(At, o0); PG8_STAGE(PG8_SA1(1), a1 + hstep, voffA); PG8_STAGE(o2, a2, voffA);
            PG8_WAIT_V(10); PG8_WAIT_L(0); PG8_BAR; PG8_MMA(0, 0, At, B0); PG8_MMA(0, 1, At, B1); PG8_BAR; PG8_SCHED;
            PG8_LDA(At, PG8_SA1(0)); PG8_STAGE(PG8_SB(0, 0), b2, voffB); PG8_STAGE(PG8_SB(0, 1), b2 + hstep, voffB);
            PG8_WAIT_V(8); PG8_WAIT_L(0); PG8_BAR; PG8_MMA(1, 0, At, B0); PG8_MMA(1, 1, At, B1); PG8_BAR; PG8_SCHED;
            PG8_LDB(B0, 1, 0); PG8_LDB(B1, 1, 1); PG8_SCHED; PG8_LDA(At, o1); PG8_STAGE(PG8_SA1(0), a2 + hstep, voffA); PG8_STAGE(o0, a3, voffA);
            PG8_WAIT_V(10); PG8_WAIT_L(0); PG8_BAR; PG8_MMA(0, 0, At, B0); PG8_MMA(0, 1, At, B1); PG8_BAR; PG8_SCHED;
            PG8_LDA(At, PG8_SA1(1)); PG8_STAGE(PG8_SB(1, 0), b3, voffB); PG8_STAGE(PG8_SB(1, 1), b3 + hstep, voffB);
            PG8_WAIT_V(8); PG8_WAIT_L(0); PG8_BAR; PG8_MMA(1, 0, At, B0); PG8_MMA(1, 1, At, B1); PG8_BAR; PG8_SCHED;
            { const int t_ = o0; o0 = o2; o2 = o1; o1 = t_; }
        }
        if constexpr (ALIGN_EPI) { if (wr == 0) PG8_BAR; }
        E(acc, cur, wr, wc, fr, fq);
        if (!has_next) break;
#pragma unroll
        for (int a = 0; a < 2; ++a)
#pragma unroll
            for (int b = 0; b < 2; ++b)
#pragma unroll
                for (int m = 0; m < 4; ++m)
#pragma unroll
                    for (int n = 0; n < 2; ++n) acc[a][b][m][n] = (f32x4){0.f, 0.f, 0.f, 0.f};
        cur = nxt; cA = nA; cB = nB; ++ui;
        if constexpr (ALIGN_EPI) { if (wr == 1) PG8_BAR; }
    }
    PG8_WAIT_V(0);
    if constexpr (!ALIGN_EPI) { if (wr == 0) PG8_BAR; }
    PG8_BAR;
#undef PG8_SA1
#undef PG8_SB
#undef PG8_STAGE
#undef PG8_LDA
#undef PG8_LDB
#undef PG8_MMA
#undef PG8_WAIT_V
#undef PG8_WAIT_L
#undef PG8_BAR
#undef PG8_SCHED
#undef PG8_ABASE
#undef PG8_BBASE
}
}

#define XB_TMO      128
#define XB_XCNT(j)  (256  + 64 * (j))
#define XB_XSUB(j)  (1280 + 64 * (j))
#define XB_XGEN(j)  (2304 + 64 * (j))
#define XB_TOP      3328
#define XB_TOPGEN   3392
#define XCD_BAR_WORDS 3456
#define XB_SPIN_CAP (1u << 18)
__device__ __forceinline__ unsigned xb_ld(unsigned* p)              { return __hip_atomic_load(p, __ATOMIC_RELAXED, __HIP_MEMORY_SCOPE_AGENT); }
__device__ __forceinline__ unsigned xb_add(unsigned* p, unsigned v) { return __hip_atomic_fetch_add(p, v, __ATOMIC_RELAXED, __HIP_MEMORY_SCOPE_AGENT); }
__device__ __forceinline__ unsigned xb_xcc_id() { return (unsigned)__builtin_amdgcn_s_getreg((3 << 11) | 20) & 0xFu; }
#define XB_SPIN(cond, bar) do { unsigned _sp = 0; while (cond) { __builtin_amdgcn_s_sleep(1); \
    if ((++_sp & 255u) == 0u) { if (xb_ld(&(bar)[XB_TMO])) break; if (_sp > XB_SPIN_CAP) { atomicAdd(&(bar)[XB_TMO], 1u); break; } } } } while (0)
struct XcdBarrier { unsigned* bar; unsigned x; volatile LAS unsigned* st; };
__device__ __forceinline__ XcdBarrier xcd_barrier_post(unsigned* bar, volatile LAS unsigned* st) {
    XcdBarrier b; b.bar = bar; b.x = xb_xcc_id(); b.st = st;
    if (threadIdx.x == 0) (void)xb_add(&bar[XB_XCNT(b.x)], 1u);
    return b;
}
__device__ __forceinline__ void xcd_barrier_complete(unsigned* bar, unsigned x, unsigned& nloc, unsigned& nx) {
    const unsigned G = gridDim.x * gridDim.y * gridDim.z;
    unsigned sum, cnt, mine, sp = 0u;
    for (;;) {
        sum = 0u; cnt = 0u; mine = 0u;
#pragma unroll
        for (unsigned j = 0; j < 16; ++j) { const unsigned c = xb_ld(&bar[XB_XCNT(j)]); sum += c; cnt += (c > 0u) ? 1u : 0u; mine = (j == x) ? c : mine; }
        if (sum == G) break;
        __builtin_amdgcn_s_sleep(1);
        if ((++sp & 255u) == 0u) { if (xb_ld(&bar[XB_TMO])) break; if (sp > XB_SPIN_CAP) { atomicAdd(&bar[XB_TMO], 1u); break; } }
    }
    nloc = mine > 0u ? mine : 1u; nx = cnt > 0u ? cnt : 1u;
}
__device__ __forceinline__ void xcd_barrier(const XcdBarrier& b) {
    asm volatile("s_waitcnt vmcnt(0)" ::: "memory");
    __syncthreads();
    if (threadIdx.x == 0) {
        unsigned* bar = b.bar;
        __builtin_amdgcn_s_waitcnt(0);
        unsigned nloc = b.st[0], nx = b.st[1];
        if (nloc == 0u) { xcd_barrier_complete(bar, b.x, nloc, nx); b.st[0] = nloc; b.st[1] = nx; }
        const unsigned old = xb_add(&bar[XB_XSUB(b.x)], 1u);
        const unsigned gen = old / nloc;
        if (old + 1u == (gen + 1u) * nloc) {
            __builtin_amdgcn_fence(__ATOMIC_RELEASE, "agent");
            asm volatile("s_waitcnt vmcnt(0)" ::: "memory");
            const unsigned og = xb_add(&bar[XB_TOP], 1u);
            const unsigned tg = og / nx;
            if (og + 1u == (tg + 1u) * nx) xb_add(&bar[XB_TOPGEN], 1u);
            else XB_SPIN(xb_ld(&bar[XB_TOPGEN]) == tg, bar);
            __builtin_amdgcn_fence(__ATOMIC_ACQUIRE, "agent");
            xb_add(&bar[XB_XGEN(b.x)], 1u);
            asm volatile("s_waitcnt vmcnt(0)" ::: "memory");
        } else {
            XB_SPIN(xb_ld(&bar[XB_XGEN(b.x)]) == gen, bar);
            __builtin_amdgcn_fence(__ATOMIC_ACQUIRE, "agent");
            asm volatile("s_waitcnt vmcnt(0)" ::: "memory");
        }
    }
    __syncthreads();
}

struct Frame {
    LAS unsigned char* lds; volatile LAS unsigned* MISC; gu32* ctl;
    int tid, lane, wave, vcu, G;
};
struct Args { const float* in[29]; float* out; unsigned char* ws; int ph_lo, ph_hi; };

__device__ __forceinline__ void ada_item(Frame& F, int it, const float* cvec, const float* ada_w, const float* ada_b, float* mod) {
    LAS float* cv = (LAS float*)F.lds;
    LAS float* red = (LAS float*)(F.lds + 32768);
    for (int i = F.tid; i < 2 * D; i += NWAVES * 64) cv[i] = cvec[i];
    __syncthreads();
    const int rs = F.lane / 24, cl = F.lane - rs * 24; const bool act = F.lane < 48;
    f32x4 a0 = (f32x4){0.f, 0.f, 0.f, 0.f}, a1 = a0;
    if (act) {
        const float* wp = ada_w + (size_t)(2 * F.wave + rs) * (6 * D) + it * 96 + cl * 4;
#pragma unroll 8
        for (int i = 0; i < D / 16; ++i) { const f32x4 v = *(const f32x4*)(wp + (size_t)i * 16 * (6 * D)); const int k = 16 * i + 2 * F.wave + rs; a0 += cv[k] * v; a1 += cv[D + k] * v; }
    }
#pragma unroll
    for (int e = 0; e < 4; ++e) { a0[e] += __shfl_down(a0[e], 24); a1[e] += __shfl_down(a1[e], 24); }
    if (F.lane < 24) { *(LAS f32x4*)(red + (F.wave * 2 + 0) * 96 + cl * 4) = a0; *(LAS f32x4*)(red + (F.wave * 2 + 1) * 96 + cl * 4) = a1; }
    __syncthreads();
    if (F.tid < 192) { const int b = F.tid / 96, ci = F.tid - b * 96; float s = ada_b[it * 96 + ci];
#pragma unroll
        for (int w = 0; w < 8; ++w) s += red[(w * 2 + b) * 96 + ci];
        mod[b * 6 * D + it * 96 + ci] = s; }
    __syncthreads();
}
__device__ __forceinline__ void p0_transpose_item(const float* W, int K, int N, bf16* WT, bool upmap, LAS float* scr, int item, int lane) {
    const int nblk = N / 32, kb = item / nblk, nb = item - kb * nblk, k0 = 64 * kb, n0 = 32 * nb;
    int d0 = n0; if (upmap) { const int half = n0 >= FF ? 1 : 0, j = n0 - half * FF; d0 = 256 * (j >> 7) + 128 * half + (j & 127); }
    const float* src = W + (size_t)(k0 + (lane >> 5)) * N + n0 + (lane & 31);
    float v[32];
#pragma unroll
    for (int i = 0; i < 32; ++i) v[i] = src[(size_t)(2 * i) * N];
#pragma unroll
    for (int i = 0; i < 32; ++i) scr[(2 * i + (lane >> 5)) * 33 + (lane & 31)] = v[i];
    LDS_WAIT(); asm volatile("" ::: "memory");
    const int c = lane & 7;
#pragma unroll
    for (int j = 0; j < 4; ++j) { const int n = (lane >> 3) + 8 * j; const LAS float* sp = scr + (8 * c) * 33 + n;
        v4u o; o.x = pk2w(sp[0 * 33], sp[1 * 33]); o.y = pk2w(sp[2 * 33], sp[3 * 33]); o.z = pk2w(sp[4 * 33], sp[5 * 33]); o.w = pk2w(sp[6 * 33], sp[7 * 33]);
        *(GAS v4u*)(WT + (size_t)(d0 + n) * K + k0 + 8 * c) = o; }
    LDS_WAIT(); asm volatile("" ::: "memory");
}
struct cplx { double re, im; };
__device__ __forceinline__ void s5_precompute(Frame& F, int g, const Args& a, unsigned char* ws) {
    const float* a_re = a.in[11]; const float* a_im = a.in[12]; const float* b_re = a.in[13]; const float* b_im = a.in[14]; const float* c_re = a.in[15]; const float* c_im = a.in[16]; const float* log_dt = a.in[18];
    LAS f32x2* pw = (LAS f32x2*)F.lds;
    LAS f32x2* bb = (LAS f32x2*)(F.lds + 33280);
    LAS f32x2* cm = (LAS f32x2*)(F.lds + 33280 + 8192);
    if (F.tid < NSTATE) {
        const int p = F.tid;
        const double dt = exp((double)log_dt[g]);
        const double lre = (double)a_re[g * NSTATE + p], lim = (double)a_im[g * NSTATE + p];
        const double ea = exp(lre * dt), th = lim * dt;
        const double are = ea * cos(th), aim = ea * sin(th);
        const double den = lre * lre + lim * lim;
        const double nre = are - 1.0, nim = aim;
        const double cre = (nre * lre + nim * lim) / den, cim = (nim * lre - nre * lim) / den;
        double pr = 1.0, pi = 0.0;
        pw[p] = (f32x2){1.f, 0.f};
        for (int n = 1; n <= TCH; ++n) { const double tr = pr * are - pi * aim, ti = pr * aim + pi * are; pr = tr; pi = ti; pw[n * NSTATE + p] = (f32x2){(float)pr, (float)pi}; }
        ((f32x2*)(ws + WS_A64))[g * NSTATE + p] = (f32x2){(float)pr, (float)pi};
        for (int c = 0; c < SGC; ++c) { const double br = (double)b_re[(g * NSTATE + p) * SGC + c], bi = (double)b_im[(g * NSTATE + p) * SGC + c];
            bb[p * SGC + c] = (f32x2){(float)(cre * br - cim * bi), (float)(cre * bi + cim * br)}; }
    }
    for (int i = F.tid; i < SGC * NSTATE; i += NWAVES * 64) cm[i] = (f32x2){c_re[g * SGC * NSTATE + i], c_im[g * SGC * NSTATE + i]};
    __syncthreads();
    {
        const int half = F.tid >> 8, c = (F.tid >> 4) & 15, c2 = F.tid & 15;
        float kacc[32];
#pragma unroll
        for (int t = 0; t < 32; ++t) kacc[t] = 0.f;
        for (int p = 0; p < NSTATE; ++p) {
            const f32x2 C = cm[c * NSTATE + p], B = bb[p * SGC + c2];
            const float xr = C.x * B.x - C.y * B.y, xi = C.x * B.y + C.y * B.x;
#pragma unroll
            for (int t = 0; t < 32; ++t) { const f32x2 w = pw[(32 * half + t) * NSTATE + p]; kacc[t] += xr * w.x - xi * w.y; }
        }
        bf16* kt = (bf16*)(ws + WS_KTAB) + (size_t)g * (68 * 256);
#pragma unroll
        for (int t = 0; t < 32; ++t) kt[(63 - (32 * half + t)) * 256 + c * 16 + c2] = (bf16)f2bf(kacc[t]);
        kt[(64 + 2 * half) * 256 + c * 16 + c2] = 0; kt[(65 + 2 * half) * 256 + c * 16 + c2] = 0;
    }
    {
        v4u* m2 = (v4u*)(ws + WS_M2) + (size_t)g * 16384;
        for (int vi = F.tid; vi < 16384; vi += NWAVES * 64) {
            const int ln = vi & 63, sp = (vi >> 6) & 31, rb = vi >> 11;
            const int rho = 16 * rb + (ln & 15), p = rho >> 1, ri = rho & 1, s = 2 * sp + (ln >> 5), cb = 8 * ((ln >> 4) & 1);
            const f32x2 w = pw[(TCH - 1 - s) * NSTATE + p]; float v[8];
#pragma unroll
            for (int i = 0; i < 8; ++i) { const f32x2 B = bb[p * SGC + cb + i]; v[i] = ri ? (w.x * B.y + w.y * B.x) : (w.x * B.x - w.y * B.y); }
            v4u o; o.x = pk2(v[0], v[1]); o.y = pk2(v[2], v[3]); o.z = pk2(v[4], v[5]); o.w = pk2(v[6], v[7]); m2[vi] = o;
        }
    }
    {
        v4u* m3 = (v4u*)(ws + WS_M3) + (size_t)g * 16384;
        for (int vi = F.tid; vi < 16384; vi += NWAVES * 64) {
            const int ln = vi & 63, ks = (vi >> 6) & 3, r = vi >> 8;
            const int c = ln & 15, rho0 = 32 * ks + 8 * (ln >> 4); float v[8];
#pragma unroll
            for (int i = 0; i < 8; ++i) { const int rho = rho0 + i, p = rho >> 1, ri = rho & 1; const f32x2 C = cm[c * NSTATE + p], w = pw[(r + 1) * NSTATE + p];
                v[i] = ri ? -(C.x * w.y + C.y * w.x) : (C.x * w.x - C.y * w.y); }
            v4u o; o.x = pk2(v[0], v[1]); o.y = pk2(v[2], v[3]); o.z = pk2(v[4], v[5]); o.w = pk2(v[6], v[7]); m3[vi] = o;
        }
    }
    __syncthreads();
}

__device__ __forceinline__ void adanorm_rows(Frame& F, const float* X, bf16* H, const float* gain, const float* mod, int sh_off, int sc_off) {
    const int gw = F.vcu * NWAVES + F.wave, NGW = F.G * NWAVES;
    for (int m = gw; m < M; m += NGW) {
        const GAS f32x4* xr = (const GAS f32x4*)(X + (size_t)m * D) + F.lane;
        f32x4 v[16]; float ss = 0.f;
#pragma unroll
        for (int j = 0; j < 16; ++j) { v[j] = xr[64 * j]; ss += (v[j].x * v[j].x + v[j].y * v[j].y) + (v[j].z * v[j].z + v[j].w * v[j].w); }
        const float rstd = 1.0f / sqrtf(wave_sum(ss) * (1.f / D) + EPS);
        const float* mb = mod + (m >= SEQ ? 6 * D : 0);
        GAS v2u* o8 = (GAS v2u*)(H + (size_t)m * D) + F.lane;
#pragma unroll
        for (int j = 0; j < 16; ++j) { const int col = 4 * (F.lane + 64 * j);
            const f32x4 gn = *(const f32x4*)(gain + col), sc = *(const f32x4*)(mb + sc_off + col), sh = *(const f32x4*)(mb + sh_off + col);
            const f32x4 y = v[j] * rstd * gn * (sc + 1.0f) + sh;
            v2u w; w.x = pk2a(y.x, y.y); w.y = pk2a(y.z, y.w); o8[64 * j] = w; }
    }
}
__device__ __forceinline__ void adanorm_rows_bf16(Frame& F, const bf16* X, bf16* H, const float* gain, const float* mod, int sh_off, int sc_off) {
    const int gw = F.vcu * NWAVES + F.wave, NGW = F.G * NWAVES;
    for (int m = gw; m < M; m += NGW) {
        const GAS v4u* xr = (const GAS v4u*)(X + (size_t)m * D) + F.lane;
        v4u v[8]; float ss = 0.f;
#pragma unroll
        for (int j = 0; j < 8; ++j) { v[j] = xr[64 * j];
            ss += (bflo(v[j].x) * bflo(v[j].x) + bfhi(v[j].x) * bfhi(v[j].x)) + (bflo(v[j].y) * bflo(v[j].y) + bfhi(v[j].y) * bfhi(v[j].y)) + (bflo(v[j].z) * bflo(v[j].z) + bfhi(v[j].z) * bfhi(v[j].z)) + (bflo(v[j].w) * bflo(v[j].w) + bfhi(v[j].w) * bfhi(v[j].w)); }
        const float rstd = 1.0f / sqrtf(wave_sum(ss) * (1.f / D) + EPS);
        const float* mb = mod + (m >= SEQ ? 6 * D : 0);
        GAS v4u* o16 = (GAS v4u*)(H + (size_t)m * D) + F.lane;
#pragma unroll
        for (int j = 0; j < 8; ++j) { const int col = 8 * (F.lane + 64 * j);
            const f32x4 g0 = *(const f32x4*)(gain + col), g1 = *(const f32x4*)(gain + col + 4), c0 = *(const f32x4*)(mb + sc_off + col), c1 = *(const f32x4*)(mb + sc_off + col + 4), h0 = *(const f32x4*)(mb + sh_off + col), h1 = *(const f32x4*)(mb + sh_off + col + 4);
            const f32x4 x0 = (f32x4){bflo(v[j].x), bfhi(v[j].x), bflo(v[j].y), bfhi(v[j].y)}, x1 = (f32x4){bflo(v[j].z), bfhi(v[j].z), bflo(v[j].w), bfhi(v[j].w)};
            const f32x4 y0 = x0 * rstd * g0 * (c0 + 1.0f) + h0, y1 = x1 * rstd * g1 * (c1 + 1.0f) + h1;
            v4u w; w.x = pk2a(y0[0], y0[1]); w.y = pk2a(y0[2], y0[3]); w.z = pk2a(y1[0], y1[1]); w.w = pk2a(y1[2], y1[3]); o16[64 * j] = w; }
    }
}
__device__ __forceinline__ void final_norm_rows(Frame& F, const bf16* X, float* O, const float* gain) {
    const int gw = F.vcu * NWAVES + F.wave, NGW = F.G * NWAVES;
    for (int m = gw; m < M; m += NGW) {
        const GAS v4u* xr = (const GAS v4u*)(X + (size_t)m * D) + F.lane;
        v4u v[8]; float ss = 0.f;
#pragma unroll
        for (int j = 0; j < 8; ++j) { v[j] = xr[64 * j];
            ss += (bflo(v[j].x) * bflo(v[j].x) + bfhi(v[j].x) * bfhi(v[j].x)) + (bflo(v[j].y) * bflo(v[j].y) + bfhi(v[j].y) * bfhi(v[j].y)) + (bflo(v[j].z) * bflo(v[j].z) + bfhi(v[j].z) * bfhi(v[j].z)) + (bflo(v[j].w) * bflo(v[j].w) + bfhi(v[j].w) * bfhi(v[j].w)); }
        const float rstd = 1.0f / sqrtf(wave_sum(ss) * (1.f / D) + EPS);
        GAS f32x4* o = (GAS f32x4*)(O + (size_t)m * D) + 2 * F.lane;
#pragma unroll
        for (int j = 0; j < 8; ++j) { const int col = 8 * (F.lane + 64 * j); const f32x4 g0 = *(const f32x4*)(gain + col), g1 = *(const f32x4*)(gain + col + 4);
            o[128 * j] = (f32x4){bflo(v[j].x), bfhi(v[j].x), bflo(v[j].y), bfhi(v[j].y)} * rstd * g0; o[128 * j + 1] = (f32x4){bflo(v[j].z), bfhi(v[j].z), bflo(v[j].w), bfhi(v[j].w)} * rstd * g1; }
    }
}

__device__ __forceinline__ float gelu_tanh(float y) { const float t = 0.7978845608028654f * (y + 0.044715f * y * y * y); return y * __builtin_amdgcn_rcpf(1.0f + __builtin_amdgcn_exp2f(-2.0f * LOG2E * t)); }
__device__ __forceinline__ void s5_unit(Frame& F, int g, int b, const bf16* U, bf16* Z, const unsigned char* ws, const float* dskip) {
    constexpr int KT_BYTES = 68 * 512, M3_OFF = KT_BYTES, SB_OFF = KT_BYTES + 32768;
    LAS unsigned char* lds = F.lds;
    LAS float* SB = (LAS float*)(lds + SB_OFF);
    const int lane = F.lane, w = F.wave, j = lane & 15, lg = lane >> 4, tid = F.tid;
    const unsigned tok0 = (unsigned)b * SEQ + (unsigned)(16 * w + j) * TCH;
    const unsigned uoff = ((tok0 + (lg >> 1)) * QK_PITCH + g * SGC + 8 * (lg & 1)) * 2u;
    bf16x8 uf[32];
#pragma unroll
    for (int sp = 0; sp < 32; ++sp) uf[sp] = *(const bf16x8*)((const char*)U + (uoff + (unsigned)(2 * sp) * QK_PITCH * 2u));
    {
        const v4u* m2g = (const v4u*)(ws + WS_M2) + (size_t)g * 16384;
        v4u st[4];
#pragma unroll
        for (int i = 0; i < 4; ++i) st[i] = m2g[tid + 512 * i];
#pragma unroll
        for (int i = 0; i < 4; ++i) *(LAS v4u*)(lds + (tid + 512 * i) * 16) = st[i];
        __syncthreads();
#pragma unroll 1
        for (int rb = 0; rb < 8; ++rb) {
            if (rb + 1 < 8) {
#pragma unroll
                for (int i = 0; i < 4; ++i) st[i] = m2g[(rb + 1) * 2048 + tid + 512 * i]; }
            const LAS unsigned char* mb = lds + (rb & 1) * 32768 + lane * 16;
            f32x4 acc = (f32x4){0.f, 0.f, 0.f, 0.f};
#pragma unroll
            for (int sp = 0; sp < 32; ++sp) acc = __builtin_amdgcn_mfma_f32_16x16x32_bf16(*(const LAS bf16x8*)(mb + sp * 1024), uf[sp], acc, 0, 0, 0);
            *(LAS f32x4*)(SB + (16 * w + j) * 128 + 16 * rb + 4 * lg) = acc;
            if (rb + 1 < 8) {
#pragma unroll
                for (int i = 0; i < 4; ++i) *(LAS v4u*)(lds + ((rb + 1) & 1) * 32768 + (tid + 512 * i) * 16) = st[i]; }
            __syncthreads();
        }
    }
    const v4u* m3g = (const v4u*)(ws + WS_M3) + (size_t)g * 16384;
    { const v4u* src = (const v4u*)(ws + WS_KTAB + (size_t)g * KT_BYTES); for (int i = tid; i < KT_BYTES / 16; i += NWAVES * 64) *(LAS v4u*)(lds + i * 16) = src[i];
#pragma unroll
      for (int i = 0; i < 2; ++i) *(LAS v4u*)(lds + M3_OFF + (tid + 512 * i) * 16) = m3g[tid + 512 * i]; }
    if (w == 0) {
        const f32x2 a = ((const f32x2*)(ws + WS_A64))[g * NSTATE + lane];
        float xr = 0.f, xi = 0.f;
        for (int c = 0; c < NCH; ++c) { LAS f32x2* sp = (LAS f32x2*)(SB + c * 128) + lane; const f32x2 s = *sp; *sp = (f32x2){xr, xi};
            const float nr = a.x * xr - a.y * xi + s.x, ni = a.x * xi + a.y * xr + s.y; xr = nr; xi = ni; }
    }
    __syncthreads();
    LAS unsigned char* xfb = (LAS unsigned char*)(SB + 16 * w * 128) + lane * 16;
    { v4u t[4];
#pragma unroll
      for (int ks = 0; ks < 4; ++ks) { const LAS f32x4* xp = (const LAS f32x4*)(SB + (16 * w + j) * 128 + 32 * ks + 8 * lg); const f32x4 x0 = xp[0], x1 = xp[1];
          t[ks].x = pk2(x0[0], x0[1]); t[ks].y = pk2(x0[2], x0[3]); t[ks].z = pk2(x1[0], x1[1]); t[ks].w = pk2(x1[2], x1[3]); }
      asm volatile("s_waitcnt lgkmcnt(0)" : "+v"(t[0]), "+v"(t[1]), "+v"(t[2]), "+v"(t[3]) :: "memory");
#pragma unroll
      for (int ks = 0; ks < 4; ++ks) *(LAS v4u*)(xfb + ks * 1024) = t[ks]; }
    const f32x4 dsk = *(const f32x4*)(dskip + g * SGC + 4 * lg);
    const int klane = (60 + (lg >> 1)) * 512 + (lane & 15) * 32 + 16 * (lg & 1);
#pragma unroll 1
    for (int R = 0; R < 16; ++R) {
        v4u st2[2];
        if (R + 1 < 16) {
#pragma unroll
            for (int i = 0; i < 2; ++i) st2[i] = m3g[(R + 1) * 1024 + tid + 512 * i]; }
        const LAS unsigned char* m3b = lds + M3_OFF + (R & 1) * 16384 + lane * 16;
        const LAS unsigned char* kp = lds + (klane - 2048 * R);
        f32x4 acc[4];
#pragma unroll
        for (int r = 0; r < 4; ++r) { acc[r] = (f32x4){0.f, 0.f, 0.f, 0.f};
#pragma unroll
            for (int ks = 0; ks < 4; ++ks) acc[r] = __builtin_amdgcn_mfma_f32_16x16x32_bf16(*(const LAS bf16x8*)(m3b + (r * 4 + ks) * 1024), *(const LAS bf16x8*)(xfb + ks * 1024), acc[r], 0, 0, 0); }
#pragma unroll
        for (int sp = 0; sp < 32; ++sp) {
            if (2 * sp <= 4 * R + 3) {
#pragma unroll
                for (int r = 0; r < 4; ++r) { const bf16x8 kf = *(const LAS bf16x8*)(kp + (2 * sp - r + 3) * 512);
                    acc[r] = __builtin_amdgcn_mfma_f32_16x16x32_bf16(kf, uf[sp], acc[r], 0, 0, 0); }
            }
        }
#pragma unroll
        for (int r = 0; r < 4; ++r) {
            const unsigned tok = tok0 + 4 * R + r;
            const v2u uu = *(const v2u*)((const char*)U + (tok * QK_PITCH + g * SGC + 4 * lg) * 2u);
            const float y0 = acc[r][0] + dsk[0] * bflo(uu.x), y1 = acc[r][1] + dsk[1] * bfhi(uu.x), y2 = acc[r][2] + dsk[2] * bflo(uu.y), y3 = acc[r][3] + dsk[3] * bfhi(uu.y);
            v2u o; o.x = pk2a(gelu_tanh(y0), gelu_tanh(y1)); o.y = pk2a(gelu_tanh(y2), gelu_tanh(y3));
            *(v2u*)((char*)Z + (tok * SW + g * SGC + 4 * lg) * 2u) = o;
        }
        if (R + 1 < 16) {
#pragma unroll
            for (int i = 0; i < 2; ++i) *(LAS v4u*)(lds + M3_OFF + ((R + 1) & 1) * 16384 + (tid + 512 * i) * 16) = st2[i]; }
        __syncthreads();
    }
}

__device__ __forceinline__ void kmax_task(Frame& F, const bf16* QKVU, unsigned* kmaxw) {
    LAS float* red = (LAS float*)F.lds;
    for (int blk = F.vcu; blk < M / 64; blk += F.G) {
        float mx[4] = {0.f, 0.f, 0.f, 0.f};
        for (int tt = 0; tt < 8; ++tt) {
            const v4u* kp = (const v4u*)(QKVU + (size_t)(blk * 64 + F.wave * 8 + tt) * QK_PITCH + 2048);
#pragma unroll
            for (int i = 0; i < 4; ++i) { const v4u c = kp[F.lane + 64 * i];
                float sq = bflo(c.x) * bflo(c.x) + bfhi(c.x) * bfhi(c.x) + bflo(c.y) * bflo(c.y) + bfhi(c.y) * bfhi(c.y) + bflo(c.z) * bflo(c.z) + bfhi(c.z) * bfhi(c.z) + bflo(c.w) * bflo(c.w) + bfhi(c.w) * bfhi(c.w);
                sq += __shfl_xor(sq, 1); sq += __shfl_xor(sq, 2); sq += __shfl_xor(sq, 4);
                mx[i] = fmaxf(mx[i], sq); }
        }
        if ((F.lane & 7) == 0) {
#pragma unroll
            for (int i = 0; i < 4; ++i) red[F.wave * 32 + (F.lane >> 3) + 8 * i] = mx[i]; }
        __syncthreads();
        if (F.tid < 32) { float m = red[F.tid];
#pragma unroll
            for (int w = 1; w < 8; ++w) m = fmaxf(m, red[w * 32 + F.tid]);
            atomicMax(kmaxw + (blk >= (SEQ / 64) ? 32 : 0) + F.tid, __builtin_bit_cast(unsigned, m)); }
        __syncthreads();
    }
}

namespace att {
constexpr float THR_SKIP = 32.f;
constexpr float THR_RESC = 6.f;
__device__ __forceinline__ unsigned off_b(unsigned row, unsigned ch) { return 256u * row + 16u * (ch ^ (((row & 3) << 2) | ((row >> 2) & 3))); }
__device__ __forceinline__ int crow(int r, int hi) { return (r & 3) + 8 * (r >> 2) + 4 * hi; }
__device__ __forceinline__ void glds16(const void* gsrc, unsigned lds_dst) { unsigned keep;
    asm volatile("s_mov_b32 %0, m0\n\ts_mov_b32 m0, %2\n\ts_nop 0\n\tglobal_load_lds_dwordx4 %1, off\n\ts_mov_b32 m0, %0" : "=&s"(keep) : "v"(gsrc), "s"(lds_dst) : "memory"); }
__device__ __forceinline__ void attn_unit(Frame& F, int b, int h, int qb, const bf16* QKVU, bf16* ATT, float lam, const float* subln_g, const unsigned* kmaxw) {
    LAS unsigned char* lds = F.lds;
    LAS unsigned* flg = (LAS unsigned*)(lds + 98304);
    const int tid = F.tid, lane = F.lane, wid = F.wave, jh = wid >> 2, qg = wid & 3, r32 = lane & 31, hi = lane >> 5;
    const int q0 = qb * 128, qw0 = q0 + 32 * qg; const size_t rowbase = (size_t)b * SEQ;
    const float slope2 = __builtin_amdgcn_exp2f(-0.5f * (float)(h + 1)) * LOG2E;
    bf16x8 qr[4];
    { const bf16* Qp = QKVU + (rowbase + qw0 + r32) * QK_PITCH + h * 128 + jh * 64 + hi * 8;
#pragma unroll
      for (int d0 = 0; d0 < 4; ++d0) qr[d0] = *(const bf16x8*)(Qp + d0 * 16); }
    float cbound;
    { float qn2 = 0.f;
#pragma unroll
      for (int d0 = 0; d0 < 4; ++d0)
#pragma unroll
          for (int e = 0; e < 8; ++e) { const float v = __builtin_bit_cast(float, (unsigned)(unsigned short)qr[d0][e] << 16); qn2 += v * v; }
      qn2 += __shfl_xor(qn2, 32);
      cbound = sqrtf(qn2 * __builtin_bit_cast(float, kmaxw[b * 32 + h * 2 + jh])) * 1.002f + 0.05f; }
    const int NT = (q0 + 128) / 64;
    const char* kbase = (const char*)(QKVU + rowbase * QK_PITCH + 2048 + h * 128);
    const unsigned lds0 = (unsigned)(uintptr_t)lds;
    unsigned koffs[2];
#pragma unroll
    for (int i = 0; i < 2; ++i) { const unsigned row = 4u * (2 * wid + i) + (lane >> 4), ch = (lane & 15) ^ (((row & 3) << 2) | ((row >> 2) & 3)); koffs[i] = (row * QK_PITCH + ch * 8) * 2u; }
#define ATT_DMA(tile, slot) do { const char* kt_ = kbase + (size_t)(tile) * (64 * QK_PITCH * 2); const unsigned sb_ = lds0 + (unsigned)(slot) * 32768u + (unsigned)wid * 2048u; \
        glds16(kt_ + koffs[0], sb_); glds16(kt_ + koffs[1], sb_ + 1024u); glds16(kt_ + 4096 + koffs[0], sb_ + 16384u); glds16(kt_ + 4096 + koffs[1], sb_ + 16384u + 1024u); } while (0)
    ATT_DMA(NT - 1, 0); ATT_DMA(NT - 2, 1);
    unsigned koff[4];
#pragma unroll
    for (int d0 = 0; d0 < 4; ++d0) koff[d0] = off_b(r32, jh * 8 + 2 * d0 + hi);
    unsigned vb[4][2];
    { const unsigned q4 = (lane & 15) >> 2, b16 = (lane >> 4) & 1, p4 = lane & 3;
#pragma unroll
      for (int c = 0; c < 4; ++c)
#pragma unroll
          for (int tt = 0; tt < 2; ++tt) vb[c][tt] = off_b(8 * tt + 4 * hi + q4, 4 * c + 2 * b16 + (p4 >> 1)) + 8 * (p4 & 1); }
    float ab[16];
#pragma unroll
    for (int r = 0; r < 16; ++r) ab[r] = slope2 * (float)crow(r, hi);
    f32x16 o[4];
#pragma unroll
    for (int c = 0; c < 4; ++c)
#pragma unroll
        for (int r = 0; r < 16; ++r) o[c][r] = 0.f;
    float m_run = 0.f, l_sum = 0.f;
    bool started = false, wdone = false;
    int slot = 0;
    for (int t = NT - 1; t >= 0; --t) {
        if (t > 0) asm volatile("s_waitcnt vmcnt(4)" ::: "memory"); else asm volatile("s_waitcnt vmcnt(0)" ::: "memory");
        __builtin_amdgcn_s_barrier(); asm volatile("" ::: "memory");
        if (t < NT - 1) { const v4u f0 = *(const LAS v4u*)(flg + ((t + 1) & 1) * 8), f1 = *(const LAS v4u*)(flg + ((t + 1) & 1) * 8 + 4);
            if ((f0.x & f0.y & f0.z & f0.w & f1.x & f1.y & f1.z & f1.w) != 0u) break; }
        if (t >= 2) { const int s2 = slot >= 1 ? slot - 1 : 2; ATT_DMA(t - 2, s2); }
        const int kv0 = 64 * t;
        if (!wdone && kv0 <= qw0 + 31) {
            const LAS unsigned char* Kb = lds + slot * 32768; const LAS unsigned char* Vb = Kb + 16384;
            f32x16 p0, p1;
            { const float base = slope2 * (float)(kv0 - q0) - m_run;
#pragma unroll
              for (int r = 0; r < 16; ++r) { p0[r] = ab[r] + base; p1[r] = p0[r] + 32.f * slope2; } }
            __builtin_amdgcn_s_setprio(1);
#pragma unroll
            for (int d0 = 0; d0 < 4; ++d0) { const bf16x8 k0 = *(const LAS bf16x8*)(Kb + koff[d0]), k1 = *(const LAS bf16x8*)(Kb + 8192 + koff[d0]);
                p0 = __builtin_amdgcn_mfma_f32_32x32x16_bf16(k0, qr[d0], p0, 0, 0, 0); p1 = __builtin_amdgcn_mfma_f32_32x32x16_bf16(k1, qr[d0], p1, 0, 0, 0); }
            __builtin_amdgcn_s_setprio(0);
            if (kv0 + 63 > qw0) { const int qpos = qw0 + r32;
#pragma unroll
                for (int r = 0; r < 16; ++r) { const int kv = kv0 + crow(r, hi); if (kv > qpos) p0[r] = -INFINITY; if (kv + 32 > qpos) p1[r] = -INFINITY; } }
            float mx = fmaxf(fmaxf(p0[0], p0[1]), p1[0]), mx2 = fmaxf(fmaxf(p0[2], p0[3]), p1[1]);
            mx = fmaxf(fmaxf(mx, p1[2]), p1[3]);
#pragma unroll
            for (int r = 4; r < 16; r += 4) { mx = fmaxf(fmaxf(mx, p0[r]), p0[r + 1]); mx2 = fmaxf(fmaxf(mx2, p0[r + 2]), p0[r + 3]); mx = fmaxf(fmaxf(mx, p1[r]), p1[r + 1]); mx2 = fmaxf(fmaxf(mx2, p1[r + 2]), p1[r + 3]); }
            mx = fmaxf(mx, mx2);
            mx = fmaxf(mx, __shfl_xor(mx, 32));
            bool sub = false; float delta = 0.f;
            if (!started) { delta = mx; started = true; sub = true; }
            else if (__any(mx > THR_RESC)) { delta = fmaxf(mx, 0.f); sub = true; const float f = __builtin_amdgcn_exp2f(-delta); l_sum *= f;
#pragma unroll
                for (int c = 0; c < 4; ++c)
#pragma unroll
                    for (int r = 0; r < 16; ++r) o[c][r] *= f; }
            if (sub) { m_run += delta;
#pragma unroll
                for (int r = 0; r < 16; ++r) { p0[r] -= delta; p1[r] -= delta; } }
            float ls = 0.f, ls2 = 0.f;
#pragma unroll
            for (int r = 0; r < 16; ++r) { p0[r] = __builtin_amdgcn_exp2f(p0[r]); p1[r] = __builtin_amdgcn_exp2f(p1[r]); ls += p0[r]; ls2 += p1[r]; }
            l_sum += ls + ls2;
            bf16x8 pf[2][2];
#pragma unroll
            for (int s = 0; s < 2; ++s) { v4u a, c;
                a.x = pk2(p0[8 * s + 0], p0[8 * s + 1]); a.y = pk2(p0[8 * s + 2], p0[8 * s + 3]); a.z = pk2(p0[8 * s + 4], p0[8 * s + 5]); a.w = pk2(p0[8 * s + 6], p0[8 * s + 7]);
                c.x = pk2(p1[8 * s + 0], p1[8 * s + 1]); c.y = pk2(p1[8 * s + 2], p1[8 * s + 3]); c.z = pk2(p1[8 * s + 4], p1[8 * s + 5]); c.w = pk2(p1[8 * s + 6], p1[8 * s + 7]);
                pf[0][s] = __builtin_bit_cast(bf16x8, a); pf[1][s] = __builtin_bit_cast(bf16x8, c); }
            __builtin_amdgcn_s_setprio(1);
#pragma unroll
            for (int c = 0; c < 4; ++c) {
                const LAS unsigned char* vp0 = Vb + vb[c][0]; const LAS unsigned char* vp1 = Vb + vb[c][1];
#pragma unroll
                for (int blk = 0; blk < 2; ++blk)
#pragma unroll
                    for (int s = 0; s < 2; ++s) {
                        const s16x4 v0 = __builtin_bit_cast(s16x4, __builtin_amdgcn_ds_read_tr16_b64_v4i16((LAS s16x4*)(vp0 + 8192 * blk + 4096 * s)));
                        const s16x4 v1 = __builtin_bit_cast(s16x4, __builtin_amdgcn_ds_read_tr16_b64_v4i16((LAS s16x4*)(vp1 + 8192 * blk + 4096 * s)));
                        const bf16x8 vf = (bf16x8){v0[0], v0[1], v0[2], v0[3], v1[0], v1[1], v1[2], v1[3]};
                        o[c] = __builtin_amdgcn_mfma_f32_32x32x16_bf16(vf, pf[blk][s], o[c], 0, 0, 0);
                    }
            }
            __builtin_amdgcn_s_setprio(0);
            wdone = __all(cbound + slope2 * (float)(kv0 - 1 - q0) - m_run < -THR_SKIP);
        }
        if (lane == 0) flg[(t & 1) * 8 + wid] = wdone ? 1u : 0u;
        asm volatile("s_waitcnt lgkmcnt(0)" ::: "memory");
        slot = slot == 2 ? 0 : slot + 1;
    }
#undef ATT_DMA
    asm volatile("s_waitcnt vmcnt(0)" ::: "memory");
    __syncthreads();
    l_sum += __shfl_xor(l_sum, 32);
    const float inv = 1.0f / l_sum;
    LAS float* cmb = (LAS float*)lds;
    if (jh == 1) {
#pragma unroll
        for (int c = 0; c < 4; ++c)
#pragma unroll
            for (int r = 0; r < 16; ++r) cmb[(qg * 64 + c * 16 + r) * 64 + lane] = o[c][r] * inv;
    }
    __syncthreads();
    if (jh == 0) {
        float ss = 0.f;
#pragma unroll
        for (int c = 0; c < 4; ++c)
#pragma unroll
            for (int r = 0; r < 16; ++r) { const float v = o[c][r] * inv - lam * cmb[(qg * 64 + c * 16 + r) * 64 + lane]; o[c][r] = v; ss += v * v; }
        ss += __shfl_xor(ss, 32);
        const float rs = (1.0f / sqrtf(ss * (1.f / 128.f) + EPS)) * (1.0f - LAM_INIT);
        bf16* op = ATT + (rowbase + qw0 + r32) * AW + h * 128;
#pragma unroll
        for (int c = 0; c < 4; ++c)
#pragma unroll
            for (int k = 0; k < 4; ++k) { const int dv = 32 * c + 8 * k + 4 * hi; const f32x4 gg = *(const f32x4*)(subln_g + dv);
                v2u w; w.x = pk2a(o[c][4 * k + 0] * rs * gg[0], o[c][4 * k + 1] * rs * gg[1]); w.y = pk2a(o[c][4 * k + 2] * rs * gg[2], o[c][4 * k + 3] * rs * gg[3]);
                *(v2u*)(op + dv) = w; }
    }
    __syncthreads();
}
}

__device__ __forceinline__ void conv_fixup(Frame& F, const bf16* RAW, bf16* ACT, const float* cw, const float* cb) {
    const int gt = F.vcu * (NWAVES * 64) + F.tid, NT = F.G * NWAVES * 64;
    constexpr int C4 = FF / 4;
    for (int it = gt; it < 256 * C4; it += NT) {
        const int gi = it / C4, j4 = (it - gi * C4) * 4;
        const int na = 256 * (j4 >> 7) + (j4 & 127);
        const bool first = (gi & 127) == 0;
        f32x4 a[4], g[4];
#pragma unroll
        for (int k = 0; k < 4; ++k) {
            if (k < 2 && first) { a[k] = (f32x4){0.f, 0.f, 0.f, 0.f}; g[k] = a[k]; continue; }
            const bf16* rp = RAW + ((size_t)(k < 2 ? gi - 1 : gi) * 4 + (k < 2 ? k + 2 : k - 2)) * NUP + na;
            const v2u ua = *(const v2u*)rp, ug = *(const v2u*)(rp + 128);
            a[k] = (f32x4){bflo(ua.x), bfhi(ua.x), bflo(ua.y), bfhi(ua.y)}; g[k] = (f32x4){bflo(ug.x), bfhi(ug.x), bflo(ug.y), bfhi(ug.y)};
        }
        const f32x4 wa0 = *(const f32x4*)(cw + j4), wa1 = *(const f32x4*)(cw + NUP + j4), wa2 = *(const f32x4*)(cw + 2 * NUP + j4), ba = *(const f32x4*)(cb + j4);
        const f32x4 wg0 = *(const f32x4*)(cw + FF + j4), wg1 = *(const f32x4*)(cw + NUP + FF + j4), wg2 = *(const f32x4*)(cw + 2 * NUP + FF + j4), bg = *(const f32x4*)(cb + FF + j4);
#pragma unroll
        for (int r = 0; r < 2; ++r) {
            const f32x4 va = ba + wa0 * a[r] + wa1 * a[r + 1] + wa2 * a[r + 2], vg = bg + wg0 * g[r] + wg1 * g[r + 1] + wg2 * g[r + 2];
            v2u w; w.x = pk2a(vg[0] * sigmoidf_(vg[0]) * va[0], vg[1] * sigmoidf_(vg[1]) * va[1]); w.y = pk2a(vg[2] * sigmoidf_(vg[2]) * va[2], vg[3] * sigmoidf_(vg[3]) * va[3]);
            *(v2u*)(ACT + (size_t)(gi * 64 + r) * FF + j4) = w;
        }
    }
}

constexpr int NPH = 13;
__global__ void __launch_bounds__(NWAVES * 64, 2) fwd_kernel(Args args) {
    extern __shared__ __attribute__((aligned(16))) unsigned char lds[];
    Frame F;
    F.lds = (LAS unsigned char*)lds; F.MISC = (volatile LAS unsigned*)(F.lds + MISC_OFF);
    F.tid = threadIdx.x; F.lane = F.tid & 63; F.wave = __builtin_amdgcn_readfirstlane(F.tid >> 6);
    F.G = gridDim.x; { const int bx = blockIdx.x; F.vcu = (F.G % 8 == 0) ? (bx % 8) * (F.G / 8) + bx / 8 : bx; }
    unsigned char* ws = args.ws; F.ctl = (gu32*)(ws + WS_CTL);
    for (int u = F.tid; u < (LDS_BYTES - LDSCTL_OFF) / 4; u += NWAVES * 64) ((LAS unsigned*)(F.lds + LDSCTL_OFF))[u] = 0u;
    __syncthreads();
    XcdBarrier bar; bar.bar = (unsigned*)(F.ctl + CW_BAR); bar.x = 0; bar.st = nullptr;
    if (!MK_PER_PHASE) bar = xcd_barrier_post((unsigned*)(F.ctl + CW_BAR), F.MISC + 8);
    const int lo = args.ph_lo, hi = args.ph_hi;
#ifndef PH_MASK
#define PH_MASK 0x1fff
#endif
#define IN(k) (((PH_MASK >> (k)) & 1) && lo <= (k) && (k) < hi)
#define SEAM(k) do { if (IN(k) && IN((k) + 1)) xcd_barrier(bar); } while (0)
    const float* x = args.in[0]; float* out = args.out;
    float* mod = (float*)(ws + WS_MOD);
    bf16* WIN = (bf16*)(ws + WS_WIN); bf16* WGLU = (bf16*)(ws + WS_WGLU); bf16* WA = (bf16*)(ws + WS_WA); bf16* WS_ = (bf16*)(ws + WS_WS); bf16* WOUT = (bf16*)(ws + WS_WOUT);
    bf16* WUP = (bf16*)(ws + WS_WUP); bf16* WDN = (bf16*)(ws + WS_WDN);
    bf16* H = (bf16*)(ws + WS_H); bf16* QKVU = (bf16*)(ws + WS_QKVU); bf16* GATES = (bf16*)(ws + WS_GATES); bf16* ACT = (bf16*)(ws + WS_ACT);
    bf16* ATT = (bf16*)(ws + WS_ATT); bf16* Z = (bf16*)(ws + WS_Z); bf16* SSM = (bf16*)(ws + WS_SSM); bf16* RAW = (bf16*)(ws + WS_RAW);
    bf16* X1 = (bf16*)(ws + WS_WIN);

    if (IN(0)) {
        for (int it = F.vcu; it < 256; it += F.G) ada_item(F, it, args.in[1], args.in[2], args.in[3], mod);
        for (int g = F.vcu; g < NGRP; g += F.G) s5_precompute(F, g, args, ws);
        LAS float* scr = (LAS float*)(F.lds + F.wave * 16384);
        const int gw = F.vcu * NWAVES + F.wave, NGW = F.G * NWAVES;
        constexpr int I_IN = (D / 64) * (NIN / 32), I_GLU = (SW / 64) * (SW / 32), I_A = (AW / 64) * (D / 32), I_S = (SW / 64) * (D / 32), I_OUT = (D / 64) * (D / 32), I_UP = (D / 64) * (NUP / 32), I_DN = (FF / 64) * (D / 32);
        constexpr int NITEMS = I_IN + I_GLU + I_A + I_S + I_OUT + I_UP + I_DN;
        for (;;) {
            unsigned base = 0;
            if (F.lane == 0) base = __hip_atomic_fetch_add((unsigned*)(F.ctl + CW_QT0), 8u, __ATOMIC_RELAXED, __HIP_MEMORY_SCOPE_AGENT);
            base = (unsigned)__builtin_amdgcn_readfirstlane((int)base);
            if (base >= (unsigned)NITEMS) break;
            for (int it = (int)base; it < (int)base + 8 && it < NITEMS; ++it) {
                int r = it;
                if (r < I_IN) { p0_transpose_item(args.in[5], D, NIN, WIN, false, scr, r, F.lane); continue; } r -= I_IN;
                if (r < I_GLU) { p0_transpose_item(args.in[19], SW, SW, WGLU, false, scr, r, F.lane); continue; } r -= I_GLU;
                if (r < I_A) { p0_transpose_item(args.in[20], AW, D, WA, false, scr, r, F.lane); continue; } r -= I_A;
                if (r < I_S) { p0_transpose_item(args.in[21], SW, D, WS_, false, scr, r, F.lane); continue; } r -= I_S;
                if (r < I_OUT) { p0_transpose_item(args.in[22], D, D, WOUT, false, scr, r, F.lane); continue; } r -= I_OUT;
                if (r < I_UP) { p0_transpose_item(args.in[24], D, NUP, WUP, true, scr, r, F.lane); continue; } r -= I_UP;
                p0_transpose_item(args.in[27], FF, D, WDN, false, scr, r, F.lane);
            }
        }
    }
    SEAM(0);
    if (IN(1)) adanorm_rows(F, x, H, args.in[4], mod, 0, D);
    SEAM(1);
    if (IN(2)) {
        pg8::Gemm g{H, WIN, H, WIN, M, NIN, D}; pg8::StaticOrder S; S.init(M, NIN, F.G, (int)blockIdx.x, 0);
        pg8::EpiInProj E{QKVU, GATES, 0.125f * LOG2E};
        pg8::gemm_phase<pg8::EpiInProj>(F.lds, g, S, E);
    }
    SEAM(2);
    if (IN(3)) { kmax_task(F, QKVU, (unsigned*)(F.ctl + CW_KMAX));
        for (int u = F.vcu; u < 2 * NGRP; u += F.G) s5_unit(F, u >> 1, u & 1, QKVU + 6144, Z, ws, args.in[17]); }
    SEAM(3);
    if (IN(4)) {
        float lam; { const float v1 = args.in[6][F.lane] * args.in[7][F.lane], v2 = args.in[8][F.lane] * args.in[9][F.lane]; lam = expf(wave_sum(v1)) - expf(wave_sum(v2)) + LAM_INIT; }
        for (;;) {
            if (F.tid == 0) F.MISC[16] = __hip_atomic_fetch_add((unsigned*)(F.ctl + CW_QATT), 1u, __ATOMIC_RELAXED, __HIP_MEMORY_SCOPE_AGENT);
            __syncthreads();
            const unsigned u = F.MISC[16];
            if (u >= 2048u) break;
            const int hh = 15 - (int)(u >> 7), rem = (int)(u & 127);
            att::attn_unit(F, rem & 1, hh, 63 - (rem >> 1), QKVU, ATT, lam, args.in[10], (const unsigned*)(F.ctl + CW_KMAX));
        }
    }
    SEAM(4);
    if (IN(5)) {
        pg8::Gemm g{Z, WGLU, Z, WGLU, M, SW, SW}; pg8::StaticOrder S; S.init(M, SW, F.G, (int)blockIdx.x, 0);
        pg8::EpiGlu E{Z, SSM};
        pg8::gemm_phase<pg8::EpiGlu>(F.lds, g, S, E);
    }
    SEAM(5);
    if (IN(6)) {
        pg8::Gemm g{ATT, WA, SSM, WS_, M, D, AW}; pg8::StaticOrder S; S.init(M, D, F.G, (int)blockIdx.x, 1);
        pg8::EpiMerge E{GATES, H};
        pg8::gemm_phase<pg8::EpiMerge>(F.lds, g, S, E);
    }
    SEAM(6);
    if (IN(7)) {
        pg8::Gemm g{H, WOUT, H, WOUT, M, D, D}; pg8::StaticOrder S; S.init(M, D, F.G, (int)blockIdx.x, 0);
        pg8::EpiResid<false, true> E{x, X1, mod + 2 * D};
        pg8::gemm_phase<pg8::EpiResid<false, true>>(F.lds, g, S, E);
    }
    SEAM(7);
    if (IN(8)) adanorm_rows_bf16(F, X1, H, args.in[23], mod, 3 * D, 4 * D);
    SEAM(8);
    if (IN(9)) {
        pg8::Gemm g{H, WUP, H, WUP, M, NUP, D}; pg8::StaticOrder S; S.init(M, NUP, F.G, (int)blockIdx.x, 0);
        pg8::EpiUp E{ACT, RAW, args.in[25], args.in[26]};
        pg8::gemm_phase<pg8::EpiUp>(F.lds, g, S, E);
    }
    SEAM(9);
    if (IN(10)) conv_fixup(F, RAW, ACT, args.in[25], args.in[26]);
    SEAM(10);
    if (IN(11)) {
        pg8::Gemm g{ACT, WDN, ACT, WDN, M, D, FF}; pg8::StaticOrder S; S.init(M, D, F.G, (int)blockIdx.x, 0);
        pg8::EpiResid<true, true> E{X1, H, mod + 5 * D};
        pg8::gemm_phase<pg8::EpiResid<true, true>>(F.lds, g, S, E);
    }
    SEAM(11);
    if (IN(12)) final_norm_rows(F, H, out, args.in[28]);
#undef IN
#undef SEAM
}

extern "C" void kernel_launch(void* const* d_in, const int* in_sizes, int n_in, void* d_out, int out_size, void* d_ws, size_t ws_size, hipStream_t stream) {
    static int grid = 0;
    if (grid == 0) {
        if (n_in != 29 || in_sizes[0] != M * D || out_size != M * D || ws_size < WS_END) { fprintf(stderr, "kernel_launch: unexpected shapes (n_in %d, in0 %d, out %d, ws %zu)\n", n_in, n_in > 0 ? in_sizes[0] : -1, out_size, ws_size); grid = -1; return; }
        int dev = 0, cus = 0, per_cu = 0;
        if (hipGetDevice(&dev) != hipSuccess || hipDeviceGetAttribute(&cus, hipDeviceAttributeMultiprocessorCount, dev) != hipSuccess) { grid = -1; return; }
        if (hipFuncSetAttribute((const void*)fwd_kernel, hipFuncAttributeMaxDynamicSharedMemorySize, LDS_BYTES) != hipSuccess) { fprintf(stderr, "kernel_launch: hipFuncSetAttribute failed\n"); grid = -1; return; }
        if (hipOccupancyMaxActiveBlocksPerMultiprocessor(&per_cu, (const void*)fwd_kernel, NWAVES * 64, LDS_BYTES) != hipSuccess || per_cu < 1) fprintf(stderr, "kernel_launch: occupancy query says %d\n", per_cu);
        (void)hipGetLastError();
        grid = cus;
    }
    if (grid < 0) return;
    (void)hipMemsetAsync((char*)d_ws + WS_CTL, 0, CTL_ZERO_BYTES, stream);
    Args a{};
    for (int i = 0; i < 29; ++i) a.in[i] = (const float*)d_in[i];
    a.out = (float*)d_out; a.ws = (unsigned char*)d_ws;
#if MK_PER_PHASE
    for (int p = 0; p < NPH; ++p) { a.ph_lo = p; a.ph_hi = p + 1; hipLaunchKernelGGL(fwd_kernel, dim3(grid), dim3(NWAVES * 64), LDS_BYTES, stream, a); }
#else
    a.ph_lo = 0; a.ph_hi = NPH; hipLaunchKernelGGL(fwd_kernel, dim3(grid), dim3(NWAVES * 64), LDS_BYTES, stream, a);
#endif
}
```
